# Optimizing an MI355X kernel written in HIP

```python
import math
import jax, jax.numpy as jnp
from jax import lax
import numpy as np

D_MODEL = 1024
BATCH = 8
SEQ = 4096
DEPTH = 2

PLE_DIM = 256
D_POOL = 512
POOL_WINDOWS = (2, 4, 8, 16)
N_POOL_GROUPS = len(POOL_WINDOWS)
POOL_GROUP = D_POOL // N_POOL_GROUPS
D_ATTN = D_MODEL - D_POOL
N_HEADS = 8
HEAD_DIM = D_ATTN // N_HEADS
MOBA_BLOCK = 256
MOBA_TOPK = 3
Q_CHUNK = 32
NUM_BUCKETS = 32
MAX_DISTANCE = 128
D_FF = 2816
CONV_WIDTH = 3
EPS = 1e-6
D_IN = D_POOL + 3 * D_ATTN

kernel_name = "hybrid_pool_moba_convffn_block"


def rms_norm(x, g):
    xf = x.astype(jnp.float32)
    y = xf * lax.rsqrt(jnp.mean(xf * xf, axis=-1, keepdims=True) + EPS)
    return (y * g.astype(jnp.float32)).astype(x.dtype)


def pool_mixer(u, w_pool, pool_scale):
    B, S, _ = u.shape
    uf = u.astype(jnp.float32)
    cpad = jnp.pad(jnp.cumsum(uf, axis=1), ((0, 0), (1, 0), (0, 0)))
    pos = jnp.arange(S)
    outs = []
    for g, w in enumerate(POOL_WINDOWS):
        c_g = cpad[:, :, g * POOL_GROUP:(g + 1) * POOL_GROUP]
        lagged = jnp.pad(c_g[:, :S + 1 - w], ((0, 0), (w - 1, 0), (0, 0)))
        count = jnp.minimum(pos + 1, w).astype(jnp.float32)[None, :, None]
        mean = (c_g[:, 1:] - lagged) / count
        outs.append(mean - uf[:, :, g * POOL_GROUP:(g + 1) * POOL_GROUP])
    pooled = jnp.stack(outs, axis=2)
    mixed = jnp.einsum('bsgc,gcd->bsgd', pooled, w_pool.astype(jnp.float32))
    return (mixed.reshape(B, S, D_POOL) * pool_scale.astype(jnp.float32)).astype(u.dtype)


def rel_bucket(dist):
    n = jnp.maximum(dist, 0)
    max_exact = NUM_BUCKETS // 2
    nf = jnp.maximum(n, 1).astype(jnp.float32)
    large = max_exact + (jnp.log(nf / max_exact) / math.log(MAX_DISTANCE / max_exact)
                         * (NUM_BUCKETS - max_exact)).astype(jnp.int32)
    large = jnp.minimum(large, NUM_BUCKETS - 1)
    return jnp.where(n < max_exact, n, large)


def moba_attention(q, k, v, rel_bias):
    B, S = q.shape[0], q.shape[1]
    nb = -(-S // MOBA_BLOCK)
    s_pad = nb * MOBA_BLOCK
    pad = ((0, 0), (0, s_pad - S), (0, 0), (0, 0))
    q, k, v = [jnp.pad(t, pad).transpose(0, 2, 1, 3) for t in (q, k, v)]
    k_blk = k.reshape(B, N_HEADS, nb, MOBA_BLOCK, HEAD_DIM)
    v_blk = v.reshape(B, N_HEADS, nb, MOBA_BLOCK, HEAD_DIM)
    k_mean = jnp.mean(k_blk.astype(jnp.float32), axis=3)
    gate = jnp.einsum('bhsd,bhnd->bhsn', q.astype(jnp.float32), k_mean)
    q_blk_idx = jnp.arange(s_pad) // MOBA_BLOCK
    past = jnp.arange(nb)[None, :] < q_blk_idx[:, None]
    gate = jnp.where(past, gate, -jnp.inf)
    n_sel = min(MOBA_TOPK, nb)
    _, sel = lax.top_k(gate, n_sel)
    sel_valid = sel < q_blk_idx[:, None]

    scale = HEAD_DIM ** -0.5
    bias_t = rel_bias.astype(jnp.float32).T
    b_idx = jnp.arange(B)[:, None, None, None]
    h_idx = jnp.arange(N_HEADS)[None, :, None, None]
    key_off = jnp.arange(MOBA_BLOCK)
    n_sel_keys = n_sel * MOBA_BLOCK

    def chunk(ci):
        start = ci * Q_CHUNK
        qc = lax.dynamic_slice_in_dim(q, start, Q_CHUNK, axis=2)
        sc = lax.dynamic_slice_in_dim(sel, start, Q_CHUNK, axis=2)
        vc = lax.dynamic_slice_in_dim(sel_valid, start, Q_CHUNK, axis=2)
        t = start + jnp.arange(Q_CHUNK)
        j = start // MOBA_BLOCK
        k_sel = k_blk[b_idx, h_idx, sc]
        v_sel = v_blk[b_idx, h_idx, sc]
        key_pos = sc[..., None] * MOBA_BLOCK + key_off
        bias_sel = bias_t[h_idx[..., None], rel_bucket(t[:, None, None] - key_pos)]
        l_sel = jnp.einsum('bhqd,bhqnkd->bhqnk', qc, k_sel).astype(jnp.float32) * scale + bias_sel
        l_sel = jnp.where(vc[..., None], l_sel, -jnp.inf)
        k_own = lax.dynamic_index_in_dim(k_blk, j, axis=2, keepdims=False)
        v_own = lax.dynamic_index_in_dim(v_blk, j, axis=2, keepdims=False)
        d_own = t[:, None] - (j * MOBA_BLOCK + key_off)[None, :]
        bias_own = bias_t[:, rel_bucket(d_own)]
        l_own = jnp.einsum('bhqd,bhkd->bhqk', qc, k_own).astype(jnp.float32) * scale + bias_own
        l_own = jnp.where(d_own >= 0, l_own, -jnp.inf)
        logits = jnp.concatenate([l_sel.reshape(B, N_HEADS, Q_CHUNK, n_sel_keys), l_own], axis=-1)
        probs = jax.nn.softmax(logits, axis=-1).astype(v.dtype)
        p_sel = probs[..., :n_sel_keys].reshape(B, N_HEADS, Q_CHUNK, n_sel, MOBA_BLOCK)
        p_own = probs[..., n_sel_keys:]
        return (jnp.einsum('bhqnk,bhqnkd->bhqd', p_sel, v_sel)
                + jnp.einsum('bhqk,bhkd->bhqd', p_own, v_own))

    outs = lax.map(chunk, jnp.arange(s_pad // Q_CHUNK))
    out = outs.transpose(1, 0, 3, 2, 4).reshape(B, s_pad, N_HEADS, HEAD_DIM)[:, :S]
    return out.reshape(B, S, D_ATTN)


def conv_ffn(h, w_up, conv_w, conv_b, w_down):
    S = h.shape[1]
    gate, val = jnp.split(h @ w_up, 2, axis=-1)
    gp = jnp.pad(gate, ((0, 0), (CONV_WIDTH - 1, 0), (0, 0)))
    conv = conv_b + gp[:, 0:S] * conv_w[0]
    for kk in range(1, CONV_WIDTH):
        conv = conv + gp[:, kk:kk + S] * conv_w[kk]
    return (jax.nn.gelu(conv, approximate=True) * val) @ w_down


def setup_inputs(seed: int = 0) -> dict:
    key = jax.random.key(seed)
    ks = jax.random.split(key, 20)
    f32 = jnp.float32
    nrm = lambda k, shape, s: jax.random.normal(k, shape, f32) * s
    gain = lambda k: 1.0 + nrm(k, (DEPTH, D_MODEL), 0.05)
    return {
        "x": nrm(ks[0], (BATCH, SEQ, D_MODEL), 1.0),
        "p": nrm(ks[1], (DEPTH, BATCH, SEQ, PLE_DIM), 1.0),
        "rel_bias": nrm(ks[2], (NUM_BUCKETS, N_HEADS), 0.5),
        "g_mix_pre": gain(ks[3]),
        "g_mix_post": gain(ks[4]),
        "g_ffn_pre": gain(ks[5]),
        "g_ffn_post": gain(ks[6]),
        "w_in": nrm(ks[7], (DEPTH, D_MODEL, D_IN), D_MODEL ** -0.5),
        "w_pool": nrm(ks[8], (DEPTH, N_POOL_GROUPS, POOL_GROUP, POOL_GROUP), POOL_GROUP ** -0.5),
        "pool_scale": 1.0 + nrm(ks[9], (DEPTH, D_POOL), 0.1),
        "w_out": nrm(ks[10], (DEPTH, D_MODEL, D_MODEL), D_MODEL ** -0.5),
        "w_up": nrm(ks[11], (DEPTH, D_MODEL, 2 * D_FF), D_MODEL ** -0.5),
        "conv_w": nrm(ks[12], (DEPTH, CONV_WIDTH, D_FF), CONV_WIDTH ** -0.5),
        "conv_b": nrm(ks[13], (DEPTH, D_FF), 0.02),
        "w_down": nrm(ks[14], (DEPTH, D_FF, D_MODEL), D_FF ** -0.5),
        "w_ple": nrm(ks[15], (DEPTH, PLE_DIM, D_MODEL), PLE_DIM ** -0.5),
        "w_ple_gate": nrm(ks[16], (DEPTH, D_MODEL, D_MODEL), D_MODEL ** -0.5),
    }


def reference(x, p, rel_bias, g_mix_pre, g_mix_post, g_ffn_pre, g_ffn_post, w_in, w_pool,
              pool_scale, w_out, w_up, conv_w, conv_b, w_down, w_ple, w_ple_gate):
    B, S, _ = x.shape
    for i in range(DEPTH):
        h = rms_norm(x, g_mix_pre[i])
        proj = h @ w_in[i]
        u, q, k, v = jnp.split(proj, [D_POOL, D_POOL + D_ATTN, D_POOL + 2 * D_ATTN], axis=-1)
        y_pool = pool_mixer(u, w_pool[i], pool_scale[i])
        y_attn = moba_attention(q.reshape(B, S, N_HEADS, HEAD_DIM),
                                k.reshape(B, S, N_HEADS, HEAD_DIM),
                                v.reshape(B, S, N_HEADS, HEAD_DIM), rel_bias)
        y = jnp.concatenate([y_pool, y_attn], axis=-1) @ w_out[i]
        x = x + rms_norm(y, g_mix_post[i])
        h = rms_norm(x, g_ffn_pre[i])
        x = x + rms_norm(conv_ffn(h, w_up[i], conv_w[i], conv_b[i], w_down[i]), g_ffn_post[i])
        x = x + (p[i] @ w_ple[i]) * jax.nn.sigmoid(x @ w_ple_gate[i])
    return x
```

```cpp
#include <hip/hip_runtime.h>
#include <math.h>

namespace nv {
constexpr int D = 1024, NB = 8, S = 4096, DEPTH = 2, PLE = 256, DPOOL = 512, NG = 4, PG = 128, NH = 8, HD = 64, MBLK = 256, NBLK = 16, DFF = 2816, DIN = 2048;
constexpr int M = NB * S;
constexpr int CR = S;
constexpr float EPS = 1e-6f;

__device__ __forceinline__ float wave_sum(float v) {
#pragma unroll
    for (int o = 32; o > 0; o >>= 1) v += __shfl_xor(v, o);
    return v;
}
__global__ void __launch_bounds__(256) rms_rows(const float* __restrict__ x, const float* __restrict__ g, float* __restrict__ out, int rows) {
    const int lane = threadIdx.x & 63, row = blockIdx.x * 4 + (threadIdx.x >> 6);
    if (row >= rows) return;
    const float4* xr = (const float4*)(x + (size_t)row * D);
    float4 v[4]; float s = 0.f;
#pragma unroll
    for (int j = 0; j < 4; ++j) { v[j] = xr[lane + 64 * j]; s += v[j].x * v[j].x + v[j].y * v[j].y + v[j].z * v[j].z + v[j].w * v[j].w; }
    const float rstd = rsqrtf(wave_sum(s) * (1.f / D) + EPS);
    float4* o = (float4*)(out + (size_t)row * D);
#pragma unroll
    for (int j = 0; j < 4; ++j) { const float4 gg = ((const float4*)g)[lane + 64 * j]; float4 r; r.x = v[j].x * rstd * gg.x; r.y = v[j].y * rstd * gg.y; r.z = v[j].z * rstd * gg.z; r.w = v[j].w * rstd * gg.w; o[lane + 64 * j] = r; }
}
__global__ void __launch_bounds__(256) add_rms_rows(float* __restrict__ x, const float* __restrict__ y, const float* __restrict__ g, int rows) {
    const int lane = threadIdx.x & 63, row = blockIdx.x * 4 + (threadIdx.x >> 6);
    if (row >= rows) return;
    const float4* yr = (const float4*)(y + (size_t)row * D);
    float4 v[4]; float s = 0.f;
#pragma unroll
    for (int j = 0; j < 4; ++j) { v[j] = yr[lane + 64 * j]; s += v[j].x * v[j].x + v[j].y * v[j].y + v[j].z * v[j].z + v[j].w * v[j].w; }
    const float rstd = rsqrtf(wave_sum(s) * (1.f / D) + EPS);
    float4* o = (float4*)(x + (size_t)row * D);
#pragma unroll
    for (int j = 0; j < 4; ++j) { const float4 gg = ((const float4*)g)[lane + 64 * j]; float4 r = o[lane + 64 * j]; r.x += v[j].x * rstd * gg.x; r.y += v[j].y * rstd * gg.y; r.z += v[j].z * rstd * gg.z; r.w += v[j].w * rstd * gg.w; o[lane + 64 * j] = r; }
}
__global__ void __launch_bounds__(256) sgemm(const float* __restrict__ A, int lda, const float* __restrict__ Bm, int ldb, float* __restrict__ C, int ldc, int K) {
    __shared__ float As[8][128 + 4];
    __shared__ float Bs[8][128 + 4];
    const int tid = threadIdx.x, tx = tid & 15, ty = tid >> 4;
    const int m0 = blockIdx.y * 128, n0 = blockIdx.x * 128;
    float acc[8][8];
#pragma unroll
    for (int i = 0; i < 8; ++i)
#pragma unroll
        for (int j = 0; j < 8; ++j) acc[i][j] = 0.f;
    const float* Ap = A + (size_t)(m0 + (tid >> 1)) * lda + (tid & 1) * 4;
    const float* Bp = Bm + (size_t)(tid >> 5) * ldb + n0 + (tid & 31) * 4;
    for (int k0 = 0; k0 < K; k0 += 8) {
        const float4 av = *(const float4*)(Ap + k0);
        const float4 bv = *(const float4*)(Bp + (size_t)k0 * ldb);
        __syncthreads();
        As[(tid & 1) * 4 + 0][tid >> 1] = av.x; As[(tid & 1) * 4 + 1][tid >> 1] = av.y; As[(tid & 1) * 4 + 2][tid >> 1] = av.z; As[(tid & 1) * 4 + 3][tid >> 1] = av.w;
        *(float4*)&Bs[tid >> 5][(tid & 31) * 4] = bv;
        __syncthreads();
#pragma unroll
        for (int k = 0; k < 8; ++k) {
            float a[8], b[8];
            const float4 a0 = *(const float4*)&As[k][ty * 8], a1 = *(const float4*)&As[k][ty * 8 + 4];
            const float4 b0 = *(const float4*)&Bs[k][tx * 8], b1 = *(const float4*)&Bs[k][tx * 8 + 4];
            a[0] = a0.x; a[1] = a0.y; a[2] = a0.z; a[3] = a0.w; a[4] = a1.x; a[5] = a1.y; a[6] = a1.z; a[7] = a1.w;
            b[0] = b0.x; b[1] = b0.y; b[2] = b0.z; b[3] = b0.w; b[4] = b1.x; b[5] = b1.y; b[6] = b1.z; b[7] = b1.w;
#pragma unroll
            for (int i = 0; i < 8; ++i)
#pragma unroll
                for (int j = 0; j < 8; ++j) acc[i][j] = fmaf(a[i], b[j], acc[i][j]);
        }
    }
#pragma unroll
    for (int i = 0; i < 8; ++i) {
        float* cp = C + (size_t)(m0 + ty * 8 + i) * ldc + n0 + tx * 8;
        *(float4*)cp = make_float4(acc[i][0], acc[i][1], acc[i][2], acc[i][3]);
        *(float4*)(cp + 4) = make_float4(acc[i][4], acc[i][5], acc[i][6], acc[i][7]);
    }
}
__global__ void __launch_bounds__(256) pool_pre(const float* __restrict__ proj, float* __restrict__ pooled) {
    const int idx = blockIdx.x * 256 + threadIdx.x;
    const int t = idx / DPOOL, c = idx % DPOOL;
    const int w = 2 << (c / PG);
    const int cnt = (t + 1 < w) ? (t + 1) : w;
    float s = 0.f;
    for (int i = 0; i < cnt; ++i) s += proj[(size_t)(t - i) * DIN + c];
    pooled[(size_t)t * DPOOL + c] = s / (float)cnt - proj[(size_t)t * DIN + c];
}
__global__ void __launch_bounds__(256) scale_cols(float* __restrict__ concat, const float* __restrict__ sc) {
    const int idx = blockIdx.x * 256 + threadIdx.x; const int t = idx / DPOOL, c = idx % DPOOL;
    concat[(size_t)t * D + c] *= sc[c];
}
__global__ void __launch_bounds__(256) kmean_k(const float* __restrict__ proj, float* __restrict__ kmean) {
    const int idx = blockIdx.x * 256 + threadIdx.x;
    const int d = idx % HD, n = (idx / HD) % NBLK, h = idx / (HD * NBLK);
    float s = 0.f;
    for (int i = 0; i < MBLK; ++i) s += proj[(size_t)(n * MBLK + i) * DIN + 1024 + h * HD + d];
    kmean[idx] = s * (1.f / MBLK);
}
__device__ __forceinline__ int rel_bucket(int dist) {
    const int n = dist > 0 ? dist : 0;
    if (n < 16) return n;
    int large = 16 + (int)(logf((float)n / 16.f) / logf(8.f) * 16.f);
    return large < 31 ? large : 31;
}
__global__ void __launch_bounds__(256) attn_naive(const float* __restrict__ proj, const float* __restrict__ kmean, const float* __restrict__ rel_bias, float* __restrict__ concat) {
    __shared__ float sq[4][HD];
    __shared__ float slog[4][4 * MBLK];
    __shared__ int sblk[4][4];
    const int lane = threadIdx.x & 63, w = threadIdx.x >> 6;
    const int qidx = blockIdx.x * 4 + w; const int t = qidx % S, h = qidx / S;
    const int j = t / MBLK;
    sq[w][lane] = proj[(size_t)t * DIN + 512 + h * HD + lane];
    __syncthreads();
    float gate = -INFINITY;
    if (lane < j) { float a = 0.f; const float* km = kmean + ((size_t)h * NBLK + lane) * HD; for (int d = 0; d < HD; ++d) a = fmaf(sq[w][d], km[d], a); gate = a; }
    int nsel = 0;
    for (int it = 0; it < 3; ++it) {
        float v = gate; int idx = lane;
#pragma unroll
        for (int o = 32; o > 0; o >>= 1) { const float ov = __shfl_xor(v, o); const int oi = __shfl_xor(idx, o); if (ov > v || (ov == v && oi < idx)) { v = ov; idx = oi; } }
        if (v > -INFINITY) { if (lane == 0) sblk[w][nsel] = idx; ++nsel; }
        if (lane == idx) gate = -INFINITY;
    }
    if (lane == 0) sblk[w][nsel] = j;
    __syncthreads();
    const int nb = nsel + 1;
    float mx = -INFINITY;
    for (int sl = 0; sl < nb; ++sl) {
        const int n = sblk[w][sl];
        for (int kk = 0; kk < 4; ++kk) {
            const int key = kk * 64 + lane, kpos = n * MBLK + key;
            const float4* kp = (const float4*)(proj + (size_t)kpos * DIN + 1024 + h * HD);
            float a = 0.f;
#pragma unroll
            for (int d4 = 0; d4 < 16; ++d4) { const float4 kv = kp[d4]; a = fmaf(sq[w][4 * d4], kv.x, a); a = fmaf(sq[w][4 * d4 + 1], kv.y, a); a = fmaf(sq[w][4 * d4 + 2], kv.z, a); a = fmaf(sq[w][4 * d4 + 3], kv.w, a); }
            float lg = a * 0.125f + rel_bias[rel_bucket(t - kpos) * NH + h];
            if (kpos > t) lg = -INFINITY;
            slog[w][sl * MBLK + key] = lg; mx = fmaxf(mx, lg);
        }
    }
#pragma unroll
    for (int o = 32; o > 0; o >>= 1) mx = fmaxf(mx, __shfl_xor(mx, o));
    float sum = 0.f;
    for (int i = lane; i < nb * MBLK; i += 64) { const float e = __expf(slog[w][i] - mx); slog[w][i] = e; sum += e; }
    sum = wave_sum(sum);
    __syncthreads();
    float o = 0.f;
    for (int sl = 0; sl < nb; ++sl) {
        const int n = sblk[w][sl];
        const float* vp = proj + (size_t)(n * MBLK) * DIN + 1536 + h * HD + lane;
        for (int key = 0; key < MBLK; ++key) o = fmaf(slog[w][sl * MBLK + key], vp[(size_t)key * DIN], o);
    }
    concat[(size_t)t * D + 512 + h * HD + lane] = o / sum;
}
__global__ void __launch_bounds__(256) conv_gelu_gate(const float* __restrict__ up, const float* __restrict__ cw, const float* __restrict__ cb, float* __restrict__ hid) {
    const size_t idx = (size_t)blockIdx.x * 256 + threadIdx.x; const int t = (int)(idx / DFF), j = (int)(idx % DFF);
    float c = cb[j];
#pragma unroll
    for (int kk = 0; kk < 3; ++kk) { const int ts = t - 2 + kk; if (ts >= 0) c = fmaf(cw[kk * DFF + j], up[(size_t)ts * (2 * DFF) + j], c); }
    const float g = 0.5f * c * (1.f + tanhf(0.7978845608028654f * (c + 0.044715f * c * c * c)));
    hid[idx] = g * up[(size_t)t * (2 * DFF) + DFF + j];
}
__global__ void __launch_bounds__(256) ple_final(float* __restrict__ x, const float* __restrict__ e, const float* __restrict__ gt) {
    const size_t idx = (size_t)blockIdx.x * 256 + threadIdx.x;
    x[idx] += e[idx] / (1.f + __expf(-gt[idx]));
}
}

extern "C" void kernel_launch(void* const* d_in, const int* in_sizes, int n_in, void* d_out, int out_size, void* d_ws, size_t ws_size, hipStream_t stream) {
    using namespace nv;
    const float* x = (const float*)d_in[0]; const float* p = (const float*)d_in[1]; const float* rel_bias = (const float*)d_in[2];
    const float* g_mix_pre = (const float*)d_in[3]; const float* g_mix_post = (const float*)d_in[4]; const float* g_ffn_pre = (const float*)d_in[5]; const float* g_ffn_post = (const float*)d_in[6];
    const float* w_in = (const float*)d_in[7]; const float* w_pool = (const float*)d_in[8]; const float* pool_scale = (const float*)d_in[9]; const float* w_out = (const float*)d_in[10];
    const float* w_up = (const float*)d_in[11]; const float* conv_w = (const float*)d_in[12]; const float* conv_b = (const float*)d_in[13]; const float* w_down = (const float*)d_in[14];
    const float* w_ple = (const float*)d_in[15]; const float* w_ple_gate = (const float*)d_in[16];
    float* X = (float*)d_out;
    float* ws = (float*)d_ws;
    float* Hb = ws;                       ws += (size_t)CR * D;
    float* Proj = ws;                     ws += (size_t)CR * DIN;
    float* Pooled = ws;                   ws += (size_t)CR * DPOOL;
    float* Concat = ws;                   ws += (size_t)CR * D;
    float* Y = ws;                        ws += (size_t)CR * D;
    float* Up = ws;                       ws += (size_t)CR * 2 * DFF;
    float* Hid = ws;                      ws += (size_t)CR * DFF;
    float* E = ws;                        ws += (size_t)CR * D;
    float* Gt = ws;                       ws += (size_t)CR * D;
    float* Kmean = ws;                    ws += (size_t)NH * NBLK * HD;
    hipMemcpyAsync(X, x, (size_t)M * D * sizeof(float), hipMemcpyDeviceToDevice, stream);
    for (int i = 0; i < DEPTH; ++i) {
        for (int c = 0; c < NB; ++c) {
            float* xc = X + (size_t)c * CR * D;
            rms_rows<<<CR / 4, 256, 0, stream>>>(xc, g_mix_pre + i * D, Hb, CR);
            sgemm<<<dim3(DIN / 128, CR / 128), 256, 0, stream>>>(Hb, D, w_in + (size_t)i * D * DIN, DIN, Proj, DIN, D);
            pool_pre<<<CR * DPOOL / 256, 256, 0, stream>>>(Proj, Pooled);
            for (int g = 0; g < NG; ++g)
                sgemm<<<dim3(1, CR / 128), 256, 0, stream>>>(Pooled + g * PG, DPOOL, w_pool + ((size_t)i * NG + g) * PG * PG, PG, Concat + g * PG, D, PG);
            scale_cols<<<CR * DPOOL / 256, 256, 0, stream>>>(Concat, pool_scale + i * DPOOL);
            kmean_k<<<NH * NBLK * HD / 256, 256, 0, stream>>>(Proj, Kmean);
            attn_naive<<<NH * S / 4, 256, 0, stream>>>(Proj, Kmean, rel_bias, Concat);
            sgemm<<<dim3(D / 128, CR / 128), 256, 0, stream>>>(Concat, D, w_out + (size_t)i * D * D, D, Y, D, D);
            add_rms_rows<<<CR / 4, 256, 0, stream>>>(xc, Y, g_mix_post + i * D, CR);
            rms_rows<<<CR / 4, 256, 0, stream>>>(xc, g_ffn_pre + i * D, Hb, CR);
            sgemm<<<dim3(2 * DFF / 128, CR / 128), 256, 0, stream>>>(Hb, D, w_up + (size_t)i * D * 2 * DFF, 2 * DFF, Up, 2 * DFF, D);
            conv_gelu_gate<<<(unsigned)((size_t)CR * DFF / 256), 256, 0, stream>>>(Up, conv_w + (size_t)i * 3 * DFF, conv_b + (size_t)i * DFF, Hid);
            sgemm<<<dim3(D / 128, CR / 128), 256, 0, stream>>>(Hid, DFF, w_down + (size_t)i * DFF * D, D, Y, D, DFF);
            add_rms_rows<<<CR / 4, 256, 0, stream>>>(xc, Y, g_ffn_post + i * D, CR);
            sgemm<<<dim3(D / 128, CR / 128), 256, 0, stream>>>(p + ((size_t)i * M + (size_t)c * CR) * PLE, PLE, w_ple + (size_t)i * PLE * D, D, E, D, PLE);
            sgemm<<<dim3(D / 128, CR / 128), 256, 0, stream>>>(xc, D, w_ple_gate + (size_t)i * D * D, D, Gt, D, D);
            ple_final<<<CR * D / 256, 256, 0, stream>>>(xc, E, Gt);
        }
    }
}
```

```cpp
#include <hip/hip_runtime.h>
#include <hip/hip_bf16.h>
#include <cstdio>
#include <cstdint>
#include <cmath>
namespace pg8 {
#define PG8_LAS __attribute__((address_space(3)))
typedef unsigned short bf16_t;
typedef short bf16x8 __attribute__((ext_vector_type(8)));
typedef float f32x4 __attribute__((ext_vector_type(4)));
typedef unsigned u32x4 __attribute__((ext_vector_type(4)));
constexpr int BM = 256, BK = 64, HALF = 128, HTB = HALF * BK * 2  , STAGE_BYTES = 8 * HTB, NXCD = 8, WGM = 8;

__host__ __device__ __forceinline__ int lds_byte(int r, int c) { const int st = (r >> 4) * 2 + (c >> 5), rr = r & 15, cc = c & 31, ob = rr * 64 + cc * 2; return st * 1024 + (ob ^ (((ob >> 9) & 1) << 5)); }
__host__ __device__ __forceinline__ void stage_rc(int b, int& R, int& C) { const int st = b / 1024, sb = b % 1024, swz = sb ^ (((sb >> 9) & 1) << 5); R = (st >> 1) * 16 + swz / 64; C = (st & 1) * 32 + (swz % 64) / 2; }
__host__ __device__ __forceinline__ int perm32(int rho) { const int n = rho >> 4, i = rho & 15; return 8 * (i >> 2) + 4 * n + (i & 3); }

struct Unit { int pm, pn; };
struct Gemm { const bf16_t* A; const bf16_t* Bt; int M, N, K; };

struct StaticOrder {
    int nM, nN, nwg, G, c;
    __host__ __device__ void init(int M, int N, int G_, int c_) { nM = M / BM; nN = N / BM; nwg = nM * nN; G = G_; c = c_; }
    __host__ __device__ bool next(int i, Unit& u) const {
        const long L = (long)i * G + c; if (L >= nwg) return false;
        int wgid = (int)L; { const int q = nwg / NXCD, r = nwg % NXCD, xcd = wgid % NXCD, off = wgid / NXCD; wgid = (xcd < r ? xcd * (q + 1) : r * (q + 1) + (xcd - r) * q) + off; }
        const int nig = WGM * nN, gid = wgid / nig, fm = gid * WGM, gsz = (nM - fm) < WGM ? (nM - fm) : WGM;
        u.pm = fm + ((wgid % nig) % gsz); u.pn = (wgid % nig) / gsz; return true;
    }
    __device__ __forceinline__ void a_ready(const Unit&) const {}
    __device__ __forceinline__ void done(const Unit&) const {}
};
__device__ __forceinline__ unsigned cvt_pk_bf16(float lo, float hi) { unsigned r; asm volatile("v_cvt_pk_bf16_f32 %0, %1, %2" : "=v"(r) : "v"(lo), "v"(hi)); return r; }
typedef float f32x2 __attribute__((ext_vector_type(2)));
template <class Epi, class Sched, bool ALIGN_EPI = false, bool SP2 = false>
__device__ __forceinline__ void gemm_phase(PG8_LAS unsigned char* lds, const Gemm g, const Sched& S, const Epi& E) {
    int tid_op = threadIdx.x; asm volatile("" : "+v"(tid_op));
    const int tid = tid_op, wid = __builtin_amdgcn_readfirstlane(tid >> 6), lane = tid & 63, wr = wid >> 2, wc = wid & 3, fr = lane & 15, fq = lane >> 4;
    const int K = g.K, nt = K / BK;
    unsigned voffA[2], voffB[2];
#pragma unroll
    for (int i = 0; i < 2; ++i) { int R, C; stage_rc(tid * 16 + i * 8192, R, C); const int Rb = Epi::PERM ? ((R & ~31) + perm32(R & 31)) : R;
        voffA[i] = (unsigned)(R * K + C) * 2u; voffB[i] = (unsigned)(Rb * K + C) * 2u; }
    const size_t kstep = (size_t)(BK * 2);
    const size_t hstep = (size_t)HALF * K * 2;
    const size_t tstep = 2 * hstep;
    const unsigned ldsw = (unsigned)wid * 1024u;
    const int aoff = lds_byte(wr * 64 + fr, fq * 8), boff = lds_byte(wc * 32 + fr, fq * 8);
#define PG8_SA(b, h) (((b) * 2 + (h)) * HTB)
#define PG8_SB(b, h) ((4 + (b) * 2 + (h)) * HTB)
#define PG8_STAGE(bufoff, gbase, voff) do { _Pragma("unroll") for (int _i = 0; _i < 2; ++_i) \
        __builtin_amdgcn_global_load_lds((const unsigned*)((const char*)(gbase) + (voff)[_i]), (PG8_LAS unsigned*)(lds + (bufoff) + ldsw + _i * 8192), 16, 0, 0); } while (0)
#define PG8_LDA(dst, b, h) do { _Pragma("unroll") for (int m = 0; m < 4; ++m) _Pragma("unroll") for (int k = 0; k < 2; ++k) dst[m][k] = *(const PG8_LAS bf16x8*)(lds + PG8_SA(b, h) + aoff + m * 2048 + k * 1024); } while (0)
#define PG8_LDB(dst, b, h) do { _Pragma("unroll") for (int n = 0; n < 2; ++n) _Pragma("unroll") for (int k = 0; k < 2; ++k) dst[n][k] = *(const PG8_LAS bf16x8*)(lds + PG8_SB(b, h) + boff + n * 2048 + k * 1024); } while (0)
#define PG8_MMA(ai, bj, At, Bt) do { __builtin_amdgcn_s_setprio(1); _Pragma("unroll") for (int m = 0; m < 4; ++m) _Pragma("unroll") for (int n = 0; n < 2; ++n) _Pragma("unroll") for (int k = 0; k < 2; ++k) \
        acc[ai][bj][m][n] = __builtin_amdgcn_mfma_f32_16x16x32_bf16(Bt[n][k], At[m][k], acc[ai][bj][m][n], 0, 0, 0); __builtin_amdgcn_s_setprio(0); } while (0)
#define PG8_WAIT_V(n) asm volatile("s_waitcnt vmcnt(" #n ")" ::: "memory")
#define PG8_WAIT_L(n) asm volatile("s_waitcnt lgkmcnt(" #n ")" ::: "memory")
#define PG8_BAR __builtin_amdgcn_s_barrier()
#define PG8_SCHED __builtin_amdgcn_sched_barrier(0)
    Unit cur, nxt; int ui = 0;
    if (!S.next(0, cur)) return;
    f32x4 acc[2][2][4][2];
#pragma unroll
    for (int a = 0; a < 2; ++a)
#pragma unroll
        for (int b = 0; b < 2; ++b)
#pragma unroll
            for (int m = 0; m < 4; ++m)
#pragma unroll
                for (int n = 0; n < 2; ++n) acc[a][b][m][n] = (f32x4){0.f, 0.f, 0.f, 0.f};
    bf16x8 At[4][2], B0[2][2], B1[2][2];
    const char* cA = (const char*)g.A + (size_t)cur.pm * tstep; const char* cB = (const char*)g.Bt + (size_t)cur.pn * tstep;
    S.a_ready(cur);
    if constexpr (SP2) {
        PG8_STAGE(PG8_SB(0, 0), cB, voffB); PG8_STAGE(PG8_SB(0, 1), cB + hstep, voffB); PG8_STAGE(PG8_SA(0, 0), cA, voffA); PG8_STAGE(PG8_SA(0, 1), cA + hstep, voffA);
        if (wr == 1) PG8_BAR;
        PG8_WAIT_V(2); PG8_BAR;
        PG8_STAGE(PG8_SB(1, 0), cB + kstep, voffB); PG8_STAGE(PG8_SA(1, 0), cA + kstep, voffA); PG8_STAGE(PG8_SB(1, 1), cB + hstep + kstep, voffB);
        PG8_WAIT_V(6); PG8_BAR;
    } else {
        PG8_STAGE(PG8_SB(0, 0), cB, voffB); PG8_STAGE(PG8_SA(0, 0), cA, voffA); PG8_STAGE(PG8_SB(0, 1), cB + hstep, voffB); PG8_STAGE(PG8_SA(0, 1), cA + hstep, voffA);
        if (wr == 1) PG8_BAR;
        PG8_WAIT_V(4); PG8_BAR;
        PG8_STAGE(PG8_SB(1, 0), cB + kstep, voffB); PG8_STAGE(PG8_SA(1, 0), cA + kstep, voffA); PG8_STAGE(PG8_SB(1, 1), cB + hstep + kstep, voffB);
        PG8_WAIT_V(6); PG8_BAR;
    }
    for (;;) {
        const bool has_next = S.next(ui + 1, nxt);
        const char* nA = has_next ? (const char*)g.A + (size_t)nxt.pm * tstep : cA; const char* nB = has_next ? (const char*)g.Bt + (size_t)nxt.pn * tstep : cB;
        for (int t = 0; t < nt; t += 2) {
            const bool last = (t == nt - 2);
            const char* a1 = cA + (size_t)(t + 1) * kstep;
            const char* a2 = last ? nA : cA + (size_t)(t + 2) * kstep; const char* b2 = last ? nB : cB + (size_t)(t + 2) * kstep;
            const char* a3 = a2 + kstep; const char* b3 = b2 + kstep;
            if (last && has_next) S.a_ready(nxt);
            if constexpr (SP2) {
            PG8_LDB(B0, 0, 0); PG8_LDB(B1, 0, 1); PG8_SCHED; PG8_LDA(At, 0, 0); PG8_STAGE(PG8_SA(1, 1), a1 + hstep, voffA);
            PG8_WAIT_V(8); PG8_WAIT_L(0); PG8_BAR; PG8_MMA(0, 0, At, B0); PG8_MMA(0, 1, At, B1); PG8_BAR; PG8_SCHED;
            PG8_LDA(At, 0, 1); PG8_STAGE(PG8_SB(0, 0), b2, voffB); PG8_STAGE(PG8_SB(0, 1), b2 + hstep, voffB); PG8_STAGE(PG8_SA(0, 0), a2, voffA);
            PG8_WAIT_V(8); PG8_WAIT_L(0); PG8_BAR; PG8_MMA(1, 0, At, B0); PG8_MMA(1, 1, At, B1); PG8_BAR; PG8_SCHED;
            PG8_LDB(B0, 1, 0); PG8_LDB(B1, 1, 1); PG8_SCHED; PG8_LDA(At, 1, 0); PG8_STAGE(PG8_SA(0, 1), a2 + hstep, voffA);
            PG8_WAIT_V(8); PG8_WAIT_L(0); PG8_BAR; PG8_MMA(0, 0, At, B0); PG8_MMA(0, 1, At, B1); PG8_BAR; PG8_SCHED;
            PG8_LDA(At, 1, 1); PG8_STAGE(PG8_SB(1, 0), b3, voffB); PG8_STAGE(PG8_SB(1, 1), b3 + hstep, voffB); PG8_STAGE(PG8_SA(1, 0), a3, voffA);
            PG8_WAIT_V(8); PG8_WAIT_L(0); PG8_BAR; PG8_MMA(1, 0, At, B0); PG8_MMA(1, 1, At, B1); PG8_BAR; PG8_SCHED;
            } else {
            PG8_LDB(B0, 0, 0); PG8_SCHED; PG8_LDA(At, 0, 0); PG8_STAGE(PG8_SA(1, 1), a1 + hstep, voffA);
            PG8_WAIT_L(8); PG8_BAR; PG8_WAIT_L(0); PG8_MMA(0, 0, At, B0); PG8_BAR; PG8_SCHED;
            PG8_LDB(B1, 0, 1); PG8_STAGE(PG8_SB(0, 0), b2, voffB);
            PG8_BAR; PG8_WAIT_L(0); PG8_MMA(0, 1, At, B1); PG8_BAR;
            PG8_LDA(At, 0, 1); PG8_STAGE(PG8_SA(0, 0), a2, voffA);
            PG8_BAR; PG8_WAIT_L(0); PG8_MMA(1, 0, At, B0); PG8_BAR; PG8_SCHED;
            PG8_STAGE(PG8_SB(0, 1), b2 + hstep, voffB);
            PG8_WAIT_V(6); PG8_BAR; PG8_MMA(1, 1, At, B1); PG8_BAR;
            PG8_LDB(B0, 1, 0); PG8_SCHED; PG8_LDA(At, 1, 0); PG8_STAGE(PG8_SA(0, 1), a2 + hstep, voffA);
            PG8_WAIT_L(8); PG8_BAR; PG8_WAIT_L(0); PG8_MMA(0, 0, At, B0); PG8_BAR; PG8_SCHED;
            PG8_LDB(B1, 1, 1); PG8_STAGE(PG8_SB(1, 0), b3, voffB);
            PG8_BAR; PG8_WAIT_L(0); PG8_MMA(0, 1, At, B1); PG8_BAR;
            PG8_LDA(At, 1, 1); PG8_STAGE(PG8_SA(1, 0), a3, voffA);
            PG8_BAR; PG8_WAIT_L(0); PG8_MMA(1, 0, At, B0); PG8_BAR; PG8_SCHED;
            PG8_STAGE(PG8_SB(1, 1), b3 + hstep, voffB);
            PG8_WAIT_V(6); PG8_BAR; PG8_MMA(1, 1, At, B1); PG8_BAR;
            }
        }
        if constexpr (ALIGN_EPI) { if (wr == 0) PG8_BAR; }
        if constexpr (!Epi::AFTER_DRAIN) { E(acc, cur, wr, wc, fr, fq); S.done(cur); }
        if (!has_next) break;
#pragma unroll
        for (int a = 0; a < 2; ++a)
#pragma unroll
            for (int b = 0; b < 2; ++b)
#pragma unroll
                for (int m = 0; m < 4; ++m)
#pragma unroll
                    for (int n = 0; n < 2; ++n) acc[a][b][m][n] = (f32x4){0.f, 0.f, 0.f, 0.f};
        cur = nxt; cA = nA; cB = nB; ++ui;
        if constexpr (ALIGN_EPI) { if (wr == 1) PG8_BAR; }
    }
    PG8_WAIT_V(0);
    if constexpr (!ALIGN_EPI) { if (wr == 0) PG8_BAR; }
    PG8_BAR;
    if constexpr (Epi::AFTER_DRAIN) { E.fused(acc, cur, wr, wc, fr, fq, lds, wid, lane); S.done(cur); }
#undef PG8_SA
#undef PG8_SB
#undef PG8_STAGE
#undef PG8_LDA
#undef PG8_LDB
#undef PG8_MMA
#undef PG8_WAIT_V
#undef PG8_WAIT_L
#undef PG8_BAR
#undef PG8_SCHED
}
}
namespace pg8 {
constexpr float QSCALE = 0.125f * 1.4426950408889634f;
template <int CTRL> __device__ __forceinline__ float dpp_mov(float old, float src) {
    return __builtin_bit_cast(float, __builtin_amdgcn_update_dpp(__builtin_bit_cast(int, old), __builtin_bit_cast(int, src), CTRL, 0xf, 0xf, false));
}
struct EpiStoreBf16 {
    static constexpr bool PERM = true, AFTER_DRAIN = false;
    bf16_t* O; int ldc;
    __device__ __forceinline__ void operator()(const f32x4 (&acc)[2][2][4][2], const Unit& u, int wr, int wc, int fr, int fq) const {
        const int row0 = u.pm * BM + wr * 64 + fr, col0 = u.pn * BM + wc * 32 + 8 * fq;
#pragma unroll
        for (int ai = 0; ai < 2; ++ai)
#pragma unroll
            for (int m = 0; m < 4; ++m) { bf16_t* rowp = O + (size_t)(row0 + ai * HALF + m * 16) * ldc + col0;
#pragma unroll
                for (int bj = 0; bj < 2; ++bj) { const f32x4 v0 = acc[ai][bj][m][0], v1 = acc[ai][bj][m][1];
                    u32x4 w; w.x = cvt_pk_bf16(v0[0], v0[1]); w.y = cvt_pk_bf16(v0[2], v0[3]); w.z = cvt_pk_bf16(v1[0], v1[1]); w.w = cvt_pk_bf16(v1[2], v1[3]);
                    *(u32x4*)(rowp + bj * HALF) = w; } }
    }
};
struct EpiIn {
    static constexpr bool PERM = true, AFTER_DRAIN = false;
    bf16_t* O; float* kms;
    __device__ __forceinline__ void operator()(const f32x4 (&acc)[2][2][4][2], const Unit& u, int wr, int wc, int fr, int fq) const {
        const int row0 = u.pm * BM + wr * 64 + fr, col0 = u.pn * BM + wc * 32 + 8 * fq;
        const float sc = (u.pn == 2 || u.pn == 3) ? QSCALE : 1.f;
#pragma unroll
        for (int ai = 0; ai < 2; ++ai)
#pragma unroll
            for (int m = 0; m < 4; ++m) { bf16_t* rowp = O + (size_t)(row0 + ai * HALF + m * 16) * 2048 + col0;
#pragma unroll
                for (int bj = 0; bj < 2; ++bj) { const f32x4 v0 = acc[ai][bj][m][0] * sc, v1 = acc[ai][bj][m][1] * sc;
                    u32x4 w; w.x = cvt_pk_bf16(v0[0], v0[1]); w.y = cvt_pk_bf16(v0[2], v0[3]); w.z = cvt_pk_bf16(v1[0], v1[1]); w.w = cvt_pk_bf16(v1[2], v1[3]);
                    *(u32x4*)(rowp + bj * HALF) = w; } }
        if (u.pn == 4 || u.pn == 5) {
#pragma unroll
            for (int bj = 0; bj < 2; ++bj)
#pragma unroll
                for (int n = 0; n < 2; ++n) {
                    f32x4 s = acc[0][bj][0][n];
#pragma unroll
                    for (int m = 1; m < 4; ++m) s += acc[0][bj][m][n];
#pragma unroll
                    for (int m = 0; m < 4; ++m) s += acc[1][bj][m][n];
#pragma unroll
                    for (int o = 1; o < 16; o <<= 1) { s[0] += __shfl_xor(s[0], o); s[1] += __shfl_xor(s[1], o); s[2] += __shfl_xor(s[2], o); s[3] += __shfl_xor(s[3], o); }
                    if (fr == 0) *(f32x4*)(kms + ((size_t)u.pm * 2 + wr) * 512 + (u.pn - 4) * 256 + bj * HALF + wc * 32 + 8 * fq + 4 * n) = s;
                }
        }
    }
};
__device__ __forceinline__ float gelu_tanh_f(float c) {
    const float z = c * (-2.3022081981f + (-0.10294324f) * (c * c));
    return c * __builtin_amdgcn_rcpf(1.0f + __builtin_amdgcn_exp2f(z));
}
struct EpiUp {
    static constexpr bool PERM = true, AFTER_DRAIN = false;
    bf16_t* H; const float* cw; const float* cb; float* sb; PG8_LAS float* X;
    __device__ __forceinline__ void operator()(const f32x4 (&acc)[2][2][4][2], const Unit& u, int wr, int wc, int fr, int fq) const {
        const int lc0 = wc * 32 + 8 * fq, hc0 = u.pn * 128 + lc0;
        f32x4 w0[2], w1[2], w2[2], bb[2];
#pragma unroll
        for (int n = 0; n < 2; ++n) { w0[n] = *(const f32x4*)(cw + hc0 + 4 * n); w1[n] = *(const f32x4*)(cw + 2816 + hc0 + 4 * n); w2[n] = *(const f32x4*)(cw + 2 * 2816 + hc0 + 4 * n); bb[n] = *(const f32x4*)(cb + hc0 + 4 * n); }
        if (fr >= 14) {
#pragma unroll
            for (int ai = 0; ai < 2; ++ai)
#pragma unroll
                for (int n = 0; n < 2; ++n) *(PG8_LAS f32x4*)(X + ((2 * ai + wr) * 2 + (fr - 14)) * 128 + lc0 + 4 * n) = acc[ai][0][3][n];
            if (wr == 1) {
#pragma unroll
                for (int n = 0; n < 2; ++n) *(f32x4*)(sb + (((size_t)u.pm * 3 + 0) * 2 + (fr - 14)) * 2816 + hc0 + 4 * n) = acc[1][0][3][n];
            }
        }
        if (fr < 2 && wr == 0) {
#pragma unroll
            for (int n = 0; n < 2; ++n) { *(f32x4*)(sb + (((size_t)u.pm * 3 + 1) * 2 + fr) * 2816 + hc0 + 4 * n) = acc[0][0][0][n];
                                          *(f32x4*)(sb + (((size_t)u.pm * 3 + 2) * 2 + fr) * 2816 + hc0 + 4 * n) = acc[0][1][0][n]; }
        }
        asm volatile("s_waitcnt lgkmcnt(0)" ::: "memory"); __builtin_amdgcn_s_barrier(); asm volatile("" ::: "memory");
#pragma unroll
        for (int ai = 0; ai < 2; ++ai) {
            const int g = 2 * ai + wr;
            f32x4 hh[2] = {(f32x4){0.f, 0.f, 0.f, 0.f}, (f32x4){0.f, 0.f, 0.f, 0.f}};
            if (g > 0 && fr >= 14) {
#pragma unroll
                for (int n = 0; n < 2; ++n) hh[n] = *(const PG8_LAS f32x4*)(X + ((g - 1) * 2 + (fr - 14)) * 128 + lc0 + 4 * n);
            }
#pragma unroll
            for (int m = 0; m < 4; ++m) {
                float o[8];
#pragma unroll
                for (int n = 0; n < 2; ++n)
#pragma unroll
                    for (int e = 0; e < 4; ++e) {
                        const float cur = acc[ai][0][m][n][e];
                        const float prv = (m == 0) ? hh[n][e] : acc[ai][0][m == 0 ? 0 : m - 1][n][e];
                        const float t1 = dpp_mov<0x121>(prv, prv);
                        const float p1 = dpp_mov<0x111>(t1, cur);
                        const float t2 = dpp_mov<0x122>(prv, prv);
                        const float p2 = dpp_mov<0x112>(t2, cur);
                        const float c = bb[n][e] + w0[n][e] * p2 + w1[n][e] * p1 + w2[n][e] * cur;
                        o[4 * n + e] = gelu_tanh_f(c) * acc[ai][1][m][n][e];
                    }
                u32x4 w; w.x = cvt_pk_bf16(o[0], o[1]); w.y = cvt_pk_bf16(o[2], o[3]); w.z = cvt_pk_bf16(o[4], o[5]); w.w = cvt_pk_bf16(o[6], o[7]);
                *(u32x4*)(H + (size_t)(u.pm * BM + ai * HALF + wr * 64 + m * 16 + fr) * 2816 + hc0) = w;
            }
        }
    }
};
struct EpiPle {
    static constexpr bool PERM = true, AFTER_DRAIN = false;
    float* Xo; const bf16_t* E;
    __device__ __forceinline__ void operator()(const f32x4 (&acc)[2][2][4][2], const Unit& u, int wr, int wc, int fr, int fq) const {
        const int col0 = u.pn * BM + wc * 32 + 8 * fq;
#pragma unroll
        for (int ai = 0; ai < 2; ++ai)
#pragma unroll
            for (int m = 0; m < 4; ++m) { const size_t off = (size_t)(u.pm * BM + ai * HALF + wr * 64 + m * 16 + fr) * 1024 + col0;
#pragma unroll
                for (int bj = 0; bj < 2; ++bj) { const size_t o2 = off + bj * HALF; const u32x4 ev = *(const u32x4*)(E + o2);
#pragma unroll
                    for (int n = 0; n < 2; ++n) { f32x4 xv = *(const f32x4*)(Xo + o2 + 4 * n); const f32x4 a = acc[ai][bj][m][n];
                        const unsigned ea = n == 0 ? ev.x : ev.z, eb = n == 0 ? ev.y : ev.w;
                        const float e0 = __builtin_bit_cast(float, ea << 16), e1 = __builtin_bit_cast(float, ea & 0xffff0000u), e2 = __builtin_bit_cast(float, eb << 16), e3 = __builtin_bit_cast(float, eb & 0xffff0000u);
                        xv[0] += e0 * __builtin_amdgcn_rcpf(1.0f + __builtin_amdgcn_exp2f(-1.4426950408889634f * a[0]));
                        xv[1] += e1 * __builtin_amdgcn_rcpf(1.0f + __builtin_amdgcn_exp2f(-1.4426950408889634f * a[1]));
                        xv[2] += e2 * __builtin_amdgcn_rcpf(1.0f + __builtin_amdgcn_exp2f(-1.4426950408889634f * a[2]));
                        xv[3] += e3 * __builtin_amdgcn_rcpf(1.0f + __builtin_amdgcn_exp2f(-1.4426950408889634f * a[3]));
                        *(f32x4*)(Xo + o2 + 4 * n) = xv; } } }
    }
};
struct EpiAny {
    static constexpr bool PERM = true, AFTER_DRAIN = false;
    int mode;
    bf16_t* O; int ldc; float* kms; const float* cw; const float* cb; float* sb; PG8_LAS float* X; float* Xo; const bf16_t* E;
    __device__ __forceinline__ void operator()(const f32x4 (&acc)[2][2][4][2], const Unit& u, int wr, int wc, int fr, int fq) const {
        asm volatile("" : "+v"(fr), "+v"(fq));
        if (mode == 0) { EpiStoreBf16 e{O, ldc}; e(acc, u, wr, wc, fr, fq); }
        else if (mode == 1) { EpiIn e{O, kms}; e(acc, u, wr, wc, fr, fq); }
        else if (mode == 2) { EpiUp e{O, cw, cb, sb, X}; e(acc, u, wr, wc, fr, fq); }
        else { EpiPle e{Xo, E}; e(acc, u, wr, wc, fr, fq); }
    }
};
}
namespace moba {
using bf16 = __hip_bfloat16;
using bf16x8 = __attribute__((ext_vector_type(8))) short;
using s16x4 = __attribute__((ext_vector_type(4))) short;
using f32x16 = __attribute__((ext_vector_type(16))) float;
using f32x4 = __attribute__((ext_vector_type(4))) float;
using u32x4 = __attribute__((ext_vector_type(4))) unsigned;
constexpr int SEQ = 4096, NHEAD = 8, PQ = 2048  , PO = 1024  ;
constexpr int SLOTB = 8192, LDS_K = 0, LDS_V = 3 * SLOTB, LDS_WS = 6 * SLOTB, LDS_OST = LDS_WS + 8 * 256, LDS_LUT = LDS_OST + 8 * 4096, LDS_KM = LDS_LUT + 512, LDS_SLAB = LDS_KM + 4096, LDS_END = LDS_SLAB + 271 * 128;
static_assert(LDS_END <= 131072, "moba LDS map");
__device__ __forceinline__ int crow(int r, int hi) { return (r & 3) + 8 * (r >> 2) + 4 * hi; }
#define SBAR() __builtin_amdgcn_sched_barrier(0)
__device__ __forceinline__ void glds16(const void* gsrc, unsigned lds_dst) { unsigned keep;
    asm volatile("s_mov_b32 %0, m0\n\ts_mov_b32 m0, %2\n\ts_nop 0\n\tglobal_load_lds_dwordx4 %1, off\n\ts_mov_b32 m0, %0" : "=&s"(keep) : "v"(gsrc), "s"(lds_dst) : "memory"); }
__device__ __forceinline__ float max3f(float a, float b, float c) { float r; asm("v_max3_f32 %0, %1, %2, %3" : "=v"(r) : "v"(a), "v"(b), "v"(c)); return r; }
__device__ __forceinline__ float max2f(float a, float b) { float r; asm("v_max_f32_e32 %0, %1, %2" : "=v"(r) : "v"(a), "v"(b)); return r; }
typedef float f32x2_t __attribute__((ext_vector_type(2))); typedef __bf16 bf16x2_t __attribute__((ext_vector_type(2)));
__device__ __forceinline__ unsigned cvtpk_s(float lo, float hi) { f32x2_t v = {lo, hi}; bf16x2_t b = __builtin_convertvector(v, bf16x2_t); return __builtin_bit_cast(unsigned, b); }
__device__ __forceinline__ void qkt(f32x16& p0, f32x16& p1, const char* Kslot, const bf16x8* qr, const f32x16& negm, int r32, int hi) {
    const char* kb = Kslot + hi * 1024 + r32 * 16;
#pragma unroll
    for (int d0 = 0; d0 < 4; ++d0) {
        const bf16x8 b0 = *reinterpret_cast<const bf16x8*>(kb + d0 * 2048);
        const bf16x8 b1 = *reinterpret_cast<const bf16x8*>(kb + d0 * 2048 + 512);
        if (d0 == 0) { p0 = __builtin_amdgcn_mfma_f32_32x32x16_bf16(b0, qr[0], negm, 0, 0, 0); p1 = __builtin_amdgcn_mfma_f32_32x32x16_bf16(b1, qr[0], negm, 0, 0, 0); }
        else { p0 = __builtin_amdgcn_mfma_f32_32x32x16_bf16(b0, qr[d0], p0, 0, 0, 0); p1 = __builtin_amdgcn_mfma_f32_32x32x16_bf16(b1, qr[d0], p1, 0, 0, 0); } }
}
__device__ __forceinline__ float rowmax(const f32x16& p0, const f32x16& p1) {
    float a = max3f(p0[0], p0[1], p1[0]), b = max3f(p0[2], p0[3], p1[1]); a = max3f(a, p1[2], p1[3]);
#pragma unroll
    for (int r = 4; r < 16; r += 4) { a = max3f(a, p0[r], p0[r + 1]); b = max3f(b, p0[r + 2], p0[r + 3]); a = max3f(a, p1[r], p1[r + 1]); b = max3f(b, p1[r + 2], p1[r + 3]); }
    const float m = max2f(a, b);
    auto rr = __builtin_amdgcn_permlane32_swap(__float_as_uint(m), __float_as_uint(m), false, false);
    return max2f(__uint_as_float(rr[0]), __uint_as_float(rr[1]));
}
__device__ __forceinline__ void pv(f32x16* o, int vb, bf16x8 pa0, bf16x8 pa1, bf16x8 pa2, bf16x8 pa3) {
#pragma unroll
    for (int d0 = 0; d0 < 2; ++d0) { s16x4 lo[4], hi[4];
#pragma unroll
        for (int ks = 0; ks < 4; ++ks) {
            asm volatile("ds_read_b64_tr_b16 %0,%1 offset:%c2" : "=&v"(lo[ks]) : "v"(vb), "i"(d0 * 4096 + ks * 1024) : "memory");
            asm volatile("ds_read_b64_tr_b16 %0,%1 offset:%c2" : "=&v"(hi[ks]) : "v"(vb), "i"(d0 * 4096 + ks * 1024 + 512) : "memory"); }
        asm volatile("s_waitcnt lgkmcnt(0)" ::: "memory"); SBAR();
#define PK(k) (bf16x8){lo[k][0], lo[k][1], lo[k][2], lo[k][3], hi[k][0], hi[k][1], hi[k][2], hi[k][3]}
        o[d0] = __builtin_amdgcn_mfma_f32_32x32x16_bf16(pa0, PK(0), o[d0], 0, 0, 0);
        o[d0] = __builtin_amdgcn_mfma_f32_32x32x16_bf16(pa1, PK(1), o[d0], 0, 0, 0);
        o[d0] = __builtin_amdgcn_mfma_f32_32x32x16_bf16(pa2, PK(2), o[d0], 0, 0, 0);
        o[d0] = __builtin_amdgcn_mfma_f32_32x32x16_bf16(pa3, PK(3), o[d0], 0, 0, 0);
#undef PK
    }
}
__device__ __forceinline__ float bf_lo(unsigned w) { return __builtin_bit_cast(float, w << 16); }
__device__ __forceinline__ float bf_hi(unsigned w) { return __builtin_bit_cast(float, w & 0xffff0000u); }

__device__ __forceinline__ void moba_unit(int b, int h, int j, const bf16* proj, bf16* concat, const float* kms, const float* lutg, char* shm) {
    int tid_op = threadIdx.x; asm volatile("" : "+v"(tid_op));
    const int tid = tid_op, lane = tid & 63, r32 = lane & 31, hi = lane >> 5; const int wid = __builtin_amdgcn_readfirstlane(tid >> 6);
    const long rowbase = (long)b * SEQ; const int q0 = j * 256;
    float* lut = (float*)(shm + LDS_LUT); float* km = (float*)(shm + LDS_KM);
    for (int i = tid; i < 271 * 8; i += 512) { const int sr = i >> 3, oc = i & 7, rr = q0 - 15 + sr;
        if (rr >= 0) { const u32x4 v = *(const u32x4*)(proj + (rowbase + rr) * PQ + 64 * h + oc * 8); *(u32x4*)(shm + LDS_SLAB + sr * 128 + oc * 16) = v; } }
    for (int i = tid; i < j * 64; i += 512) { const int n = i >> 6, d = i & 63; const float* kp = kms + ((size_t)(16 * b + n) * 2) * 512 + 64 * h + d; km[i] = (kp[0] + kp[512]) * (1.0f / 256.0f); }
    if (tid < 128) lut[tid] = lutg[h * 128 + tid];
    __syncthreads();
    { const int oc = tid & 7, rg = tid >> 3; const int w = 2 << (h >> 1);
#pragma unroll
      for (int r = 0; r < 4; ++r) { const int lr = 4 * rg + r, t = q0 + lr; const int cnt = (t + 1 < w) ? (t + 1) : w;
        float s[8];
#pragma unroll
        for (int e = 0; e < 8; ++e) s[e] = 0.f;
        for (int i = 0; i < cnt; ++i) { const u32x4 v = *(const u32x4*)(shm + LDS_SLAB + (lr + 15 - i) * 128 + oc * 16);
            s[0] += bf_lo(v.x); s[1] += bf_hi(v.x); s[2] += bf_lo(v.y); s[3] += bf_hi(v.y); s[4] += bf_lo(v.z); s[5] += bf_hi(v.z); s[6] += bf_lo(v.w); s[7] += bf_hi(v.w); }
        const u32x4 c = *(const u32x4*)(shm + LDS_SLAB + (lr + 15) * 128 + oc * 16); const float ic = 1.0f / (float)cnt;
        u32x4 o; o.x = cvtpk_s(s[0] * ic - bf_lo(c.x), s[1] * ic - bf_hi(c.x)); o.y = cvtpk_s(s[2] * ic - bf_lo(c.y), s[3] * ic - bf_hi(c.y));
        o.z = cvtpk_s(s[4] * ic - bf_lo(c.z), s[5] * ic - bf_hi(c.z)); o.w = cvtpk_s(s[6] * ic - bf_lo(c.w), s[7] * ic - bf_hi(c.w));
        *(u32x4*)(concat + (rowbase + t) * PO + 64 * h + oc * 8) = o; } }
    const bf16* Qw = proj + (rowbase + q0 + wid * 32) * PQ + 512 + h * 64;
    const bf16* Kh = proj + rowbase * PQ + 1024 + h * 64; const bf16* Vh = proj + rowbase * PQ + 1536 + h * 64;
    const unsigned lds0 = (unsigned)(uintptr_t)shm;
    float* wsf = (float*)(shm + LDS_WS) + wid * 64;
    const bf16* ksrc = Kh + (long)lane * PQ + wid * 8;
    const bf16* vsrc = Vh + (long)(16 * (wid & 3) + (lane >> 2)) * PQ + (wid >> 2) * 32 + (lane & 3) * 8;
    const unsigned kdst = lds0 + LDS_K + wid * 1024, vdst = lds0 + LDS_V + wid * 1024;
    const int vb0 = (int)(lds0 + LDS_V) + ((lane >> 4) & 1) * 32 + (lane & 3) * 8 + (4 * hi + ((lane & 15) >> 2)) * 64;
#define KROW(t) ((t) < 4 ? q0 + 64 * (t) : (j - 1 - (((t) - 4) >> 2)) * 256 + 64 * (((t) - 4) & 3))
#define DMA_KV(t, slot) do { const long kr_ = KROW(t); glds16(ksrc + kr_ * PQ, (unsigned)__builtin_amdgcn_readfirstlane(kdst + (slot))); glds16(vsrc + kr_ * PQ, (unsigned)__builtin_amdgcn_readfirstlane(vdst + (slot))); } while (0)
    const int NT = 4 * (j + 1);
    DMA_KV(0, 0);
    bf16x8 qr[4];
#pragma unroll
    for (int d0 = 0; d0 < 4; ++d0) qr[d0] = *reinterpret_cast<const bf16x8*>(&Qw[(long)r32 * PQ + d0 * 16 + hi * 8]);
    unsigned selmask = 0u;
    {
        float v1 = -INFINITY, v2 = -INFINITY, v3 = -INFINITY; int i1 = -1, i2 = -1, i3 = -1;
        u32x4 qw[4];
#pragma unroll
        for (int d0 = 0; d0 < 4; ++d0) qw[d0] = __builtin_bit_cast(u32x4, qr[d0]);
#pragma unroll 1
        for (int n = 0; n < j; ++n) {
            float a = 0.f;
#pragma unroll
            for (int d0 = 0; d0 < 4; ++d0) { const f32x4 k0 = *(const f32x4*)(km + n * 64 + 16 * d0 + 8 * hi), k1 = *(const f32x4*)(km + n * 64 + 16 * d0 + 8 * hi + 4);
                a += bf_lo(qw[d0].x) * k0[0] + bf_hi(qw[d0].x) * k0[1] + bf_lo(qw[d0].y) * k0[2] + bf_hi(qw[d0].y) * k0[3] + bf_lo(qw[d0].z) * k1[0] + bf_hi(qw[d0].z) * k1[1] + bf_lo(qw[d0].w) * k1[2] + bf_hi(qw[d0].w) * k1[3]; }
            a += __shfl_xor(a, 32);
            if (a > v1) { v3 = v2; i3 = i2; v2 = v1; i2 = i1; v1 = a; i1 = n; }
            else if (a > v2) { v3 = v2; i3 = i2; v2 = a; i2 = n; }
            else if (a > v3) { v3 = a; i3 = n; }
        }
        if (i1 >= 0) selmask |= 1u << i1;
        if (i2 >= 0) selmask |= 1u << i2;
        if (i3 >= 0) selmask |= 1u << i3;
    }
    float m_run = -INFINITY, l_reg = 0.f; f32x16 o[2]; o[0] = f32x16{}; o[1] = f32x16{}; f32x16 zero16 = f32x16{};
    const int qrel = wid * 32 + r32;
    for (int t = 0; t < NT; ++t) {
        const int slot = (t & 1) * SLOTB;
        asm volatile("s_waitcnt vmcnt(0) lgkmcnt(0)\n\ts_barrier" ::: "memory");
        if (t + 1 < NT) DMA_KV(t + 1, slot ^ SLOTB);
        const bool own = t < 4; const int blk = own ? j : j - 1 - ((t - 4) >> 2); const int kt = own ? t : ((t - 4) & 3);
        const bool rowsel = ((selmask >> blk) & 1u) != 0u;
        const bool active = own ? (64 * kt <= 32 * wid + 31) : (__ballot(rowsel) != 0ull);
        if (active) {
            f32x16 p0, p1; qkt(p0, p1, shm + LDS_K + slot, qr, zero16, r32, hi);
            if (own || blk == j - 1) {
                const int dbase = (own ? qrel : qrel + 256) - 64 * kt - 4 * hi;
                const bool keep = own || rowsel;
#pragma unroll
                for (int r = 0; r < 16; ++r) { const int d0_ = dbase - ((r & 3) + 8 * (r >> 2)), d1_ = d0_ - 32;
                    const float b0 = lut[d0_ < 0 ? 0 : (d0_ > 127 ? 127 : d0_)], b1 = lut[d1_ < 0 ? 0 : (d1_ > 127 ? 127 : d1_)];
                    p0[r] = (keep && d0_ >= 0) ? p0[r] + b0 : -INFINITY; p1[r] = (keep && d1_ >= 0) ? p1[r] + b1 : -INFINITY; }
            } else {
                const float bc = lut[127];
#pragma unroll
                for (int r = 0; r < 16; ++r) { p0[r] = rowsel ? p0[r] + bc : -INFINITY; p1[r] = rowsel ? p1[r] + bc : -INFINITY; }
            }
            const float rm = rowmax(p0, p1);
            const float mnew = fmaxf(m_run, rm);
            const float alpha = __builtin_amdgcn_exp2f(m_run - mnew);
            if (__any(mnew > m_run)) {
                if (hi == 0) wsf[r32] = alpha;
                asm volatile("s_waitcnt lgkmcnt(0)" ::: "memory");
#pragma unroll
                for (int d_ = 0; d_ < 2; ++d_)
#pragma unroll
                    for (int r = 0; r < 16; ++r) o[d_][r] *= wsf[crow(r, hi)];
            }
            m_run = mnew;
            float sacc = 0.f;
#pragma unroll
            for (int r = 0; r < 16; ++r) { p0[r] = __builtin_amdgcn_exp2f(p0[r] - mnew); p1[r] = __builtin_amdgcn_exp2f(p1[r] - mnew); sacc += p0[r] + p1[r]; }
            l_reg = l_reg * alpha + sacc;
            u32x4 pw0, pw1, pw2, pw3;
#define PKW(P, B) cvtpk_s(P[B], P[B + 1])
            pw0 = (u32x4){PKW(p0, 0), PKW(p0, 2), PKW(p0, 4), PKW(p0, 6)}; pw1 = (u32x4){PKW(p0, 8), PKW(p0, 10), PKW(p0, 12), PKW(p0, 14)};
            pw2 = (u32x4){PKW(p1, 0), PKW(p1, 2), PKW(p1, 4), PKW(p1, 6)}; pw3 = (u32x4){PKW(p1, 8), PKW(p1, 10), PKW(p1, 12), PKW(p1, 14)};
#undef PKW
            SBAR(); pv(o, vb0 + slot, __builtin_bit_cast(bf16x8, pw0), __builtin_bit_cast(bf16x8, pw1), __builtin_bit_cast(bf16x8, pw2), __builtin_bit_cast(bf16x8, pw3));
        }
    }
    { auto rr = __builtin_amdgcn_permlane32_swap(__float_as_uint(l_reg), __float_as_uint(l_reg), false, false); l_reg = __uint_as_float(rr[0]) + __uint_as_float(rr[1]); }
    if (hi == 0) wsf[32 + r32] = l_reg; asm volatile("s_waitcnt lgkmcnt(0)" ::: "memory");
    float rli[16];
#pragma unroll
    for (int r = 0; r < 16; ++r) rli[r] = __builtin_amdgcn_rcpf(wsf[32 + crow(r, hi)]);
    bf16* Ow = concat + (rowbase + q0 + wid * 32) * PO + 512 + h * 64;
    { bf16* stg = (bf16*)(shm + LDS_OST) + wid * 2048;
#pragma unroll
      for (int r = 0; r < 16; ++r) { const int orow = crow(r, hi);
#pragma unroll
        for (int d0 = 0; d0 < 2; ++d0) stg[orow * 64 + d0 * 32 + r32] = __float2bfloat16(o[d0][r] * rli[r]); }
      asm volatile("s_waitcnt lgkmcnt(0)" ::: "memory");
#pragma unroll
      for (int i = 0; i < 4; ++i) { const int row = i * 8 + (lane >> 3), ch = lane & 7; const u32x4 v = *(const u32x4*)(stg + row * 64 + ch * 8); *(u32x4*)(Ow + (long)row * PO + ch * 8) = v; } }
    asm volatile("s_waitcnt vmcnt(0) lgkmcnt(0)\n\ts_barrier" ::: "memory");
#undef KROW
#undef DMA_KV
}
#undef SBAR
}
#define GAS __attribute__((address_space(1)))
#define LAS __attribute__((address_space(3)))
typedef unsigned short bf16;
typedef unsigned v4u __attribute__((ext_vector_type(4)));
typedef float f32x4 __attribute__((ext_vector_type(4)));
typedef short bf16x8 __attribute__((ext_vector_type(8)));
typedef GAS unsigned gu32;
typedef GAS unsigned long long gu64;
#define RLX_AGENT __ATOMIC_RELAXED, __HIP_MEMORY_SCOPE_AGENT
#define LDS_WAIT() asm volatile("s_waitcnt lgkmcnt(0)" ::: "memory")
#define VM_WAIT() asm volatile("s_waitcnt vmcnt(0)" ::: "memory")
__device__ __forceinline__ unsigned long long rt() { return __builtin_amdgcn_s_memrealtime(); }
__device__ __forceinline__ unsigned f2bf(float f) { unsigned u = __builtin_bit_cast(unsigned, f); return (u + 0x7fffu + ((u >> 16) & 1u)) >> 16; }
__device__ __forceinline__ unsigned pk2(float lo, float hi) { return f2bf(lo) | (f2bf(hi) << 16); }

#define XB_TMO      128
#define XB_XCNT(j)  (256  + 64 * (j))
#define XB_XSUB(j)  (1280 + 64 * (j))
#define XB_XGEN(j)  (2304 + 64 * (j))
#define XB_TOP      3328
#define XB_TOPGEN   3392
#define XCD_BAR_WORDS 3456
#define XB_SPIN_CAP (1u << 18)

__device__ __forceinline__ unsigned xb_ld(unsigned* p)              { return __hip_atomic_load(p, __ATOMIC_RELAXED, __HIP_MEMORY_SCOPE_AGENT); }
__device__ __forceinline__ unsigned xb_add(unsigned* p, unsigned v) { return __hip_atomic_fetch_add(p, v, __ATOMIC_RELAXED, __HIP_MEMORY_SCOPE_AGENT); }
__device__ __forceinline__ unsigned xb_xcc_id() { return (unsigned)__builtin_amdgcn_s_getreg((3 << 11) | 20) & 0xFu; }
#define XB_SPIN(cond, bar) do { unsigned _sp = 0; while (cond) { __builtin_amdgcn_s_sleep(1); \
    if ((++_sp & 255u) == 0u) { if (xb_ld(&(bar)[XB_TMO])) break; if (_sp > XB_SPIN_CAP) { atomicAdd(&(bar)[XB_TMO], 1u); break; } } } } while (0)

struct XcdBarrier {
    unsigned* bar; unsigned x;
    volatile LAS unsigned* st;
};

__device__ __forceinline__ XcdBarrier xcd_barrier_post(unsigned* bar, volatile LAS unsigned* st) {
    XcdBarrier b; b.bar = bar; b.x = xb_xcc_id(); b.st = st;
    if (threadIdx.x == 0) (void)xb_add(&bar[XB_XCNT(b.x)], 1u);
    return b;
}
__device__ __forceinline__ void xcd_barrier_complete(unsigned* bar, unsigned x, unsigned& nloc, unsigned& nx) {
    const unsigned G = gridDim.x * gridDim.y * gridDim.z;
    unsigned sum, cnt, mine, sp = 0u;
    for (;;) {
        sum = 0u; cnt = 0u; mine = 0u;
#pragma unroll
        for (unsigned j = 0; j < 16; ++j) { const unsigned c = xb_ld(&bar[XB_XCNT(j)]); sum += c; cnt += (c > 0u) ? 1u : 0u; mine = (j == x) ? c : mine; }
        if (sum == G) break;
        __builtin_amdgcn_s_sleep(1);
        if ((++sp & 255u) == 0u) { if (xb_ld(&bar[XB_TMO])) break; if (sp > XB_SPIN_CAP) { atomicAdd(&bar[XB_TMO], 1u); break; } }
    }
    nloc = mine > 0u ? mine : 1u; nx = cnt > 0u ? cnt : 1u;
}

__device__ __forceinline__ void xcd_barrier(const XcdBarrier& b) {
    asm volatile("s_waitcnt vmcnt(0)" ::: "memory");
    __syncthreads();
    if (threadIdx.x == 0) {
        unsigned* bar = b.bar;
        __builtin_amdgcn_s_waitcnt(0);
        unsigned nloc = b.st[0], nx = b.st[1];
        if (nloc == 0u) { xcd_barrier_complete(bar, b.x, nloc, nx); b.st[0] = nloc; b.st[1] = nx; }
        const unsigned old = xb_add(&bar[XB_XSUB(b.x)], 1u);
        const unsigned gen = old / nloc;
        if (old + 1u == (gen + 1u) * nloc) {
            __builtin_amdgcn_fence(__ATOMIC_RELEASE, "agent");
            asm volatile("s_waitcnt vmcnt(0)" ::: "memory");
            const unsigned og = xb_add(&bar[XB_TOP], 1u);
            const unsigned tg = og / nx;
            if (og + 1u == (tg + 1u) * nx) xb_add(&bar[XB_TOPGEN], 1u);
            else XB_SPIN(xb_ld(&bar[XB_TOPGEN]) == tg, bar);
            __builtin_amdgcn_fence(__ATOMIC_ACQUIRE, "agent");
            xb_add(&bar[XB_XGEN(b.x)], 1u);
            asm volatile("s_waitcnt vmcnt(0)" ::: "memory");
        } else {
            XB_SPIN(xb_ld(&bar[XB_XGEN(b.x)]) == gen, bar);
            __builtin_amdgcn_fence(__ATOMIC_ACQUIRE, "agent");
            asm volatile("s_waitcnt vmcnt(0)" ::: "memory");
        }
    }
    __syncthreads();
}
constexpr int NWAVES = 8;
constexpr int DM = 1024, NBATCH = 8, SEQ = 4096, DEPTH = 2, PLE = 256, DFF = 2816, DIN = 2048, NHEAD = 8;
constexpr int M = NBATCH * SEQ;
constexpr float RMS_EPS = 1e-6f;
#ifndef MK_SPLIT
#define MK_SPLIT 1
#endif

constexpr size_t MiB = 1u << 20;
constexpr size_t WS_CTL = 0, CTL_ZERO_BYTES = 1 * MiB;
constexpr size_t WS_LUT = 1 * MiB;
constexpr size_t WS_KMS = 1 * MiB + 64 * 1024;
constexpr size_t WS_W = 2 * MiB, W_LAYER = 25 * MiB;
constexpr size_t OFF_WIN = 0, OFF_WOUT = 4 * MiB, OFF_WUP = 6 * MiB, OFF_WDOWN = 17 * MiB, OFF_WG = 17 * MiB + 5632 * 1024, OFF_WPLE = OFF_WG + 2 * MiB;
static_assert(OFF_WPLE + 512 * 1024 <= W_LAYER, "weights per layer");
constexpr size_t WS_SB = 52 * MiB;
constexpr size_t WS_PB = 64 * MiB;
constexpr size_t WS_E = 96 * MiB;
constexpr size_t WS_HB0 = 160 * MiB, WS_HB1 = 224 * MiB;
constexpr size_t WS_PROJ = 288 * MiB;
constexpr size_t WS_CAT = 416 * MiB;
constexpr size_t WS_HID = 288 * MiB;
constexpr size_t WS_END = 480 * MiB;
constexpr int CW_BAR = 4096;
constexpr int RING_OFF = 0, RING_BYTES = 131072, XCH_OFF = 131072  , LDSCTL_OFF = 135168, MISC_OFF = LDSCTL_OFF + 320, LDS_BYTES = 147456;

__device__ __forceinline__ float wave_sum(float v) {
#pragma unroll
    for (int o = 1; o < 64; o <<= 1) v += __shfl_xor(v, o);
    return v;
}
__device__ __forceinline__ void p0_transpose_item(const float* W, int ldw, int srccol0, const float* ks, int K, bf16* WT, int dstrow0, int k0, LAS float* scr, int lane) {
#pragma unroll 8
    for (int i = 0; i < 32; ++i) { const int kk = 2 * i + (lane >> 5); float v = W[(size_t)(k0 + kk) * ldw + srccol0 + (lane & 31)]; if (ks) v *= ks[k0 + kk]; scr[kk * 33 + (lane & 31)] = v; }
    LDS_WAIT(); asm volatile("" ::: "memory");
    const int c = lane & 7;
#pragma unroll
    for (int j = 0; j < 4; ++j) { const int n = (lane >> 3) + 8 * j; const LAS float* s = scr + (8 * c) * 33 + n;
        v4u o; o.x = pk2(s[0 * 33], s[1 * 33]); o.y = pk2(s[2 * 33], s[3 * 33]); o.z = pk2(s[4 * 33], s[5 * 33]); o.w = pk2(s[6 * 33], s[7 * 33]);
        *(GAS v4u*)(WT + (size_t)(dstrow0 + n) * K + k0 + 8 * c) = o; }
    LDS_WAIT(); asm volatile("" ::: "memory");
}
__device__ __forceinline__ void p0_pool_item(const float* Win, const float* wpool, const float* pscale, const float* g, bf16* WT, int n0, int k0, LAS float* scr, int lane) {
    const int n = n0 + (lane & 31), grp = n >> 7, nl = n & 127; const float* wp = wpool + (size_t)grp * 128 * 128 + nl; const float sc = pscale[n];
    for (int i = 0; i < 32; ++i) { const int kk = 2 * i + (lane >> 5); const float* wr_ = Win + (size_t)(k0 + kk) * DIN + grp * 128; float a = 0.f;
#pragma unroll 8
        for (int c = 0; c < 128; ++c) a = fmaf(wr_[c], wp[(size_t)c * 128], a);
        scr[kk * 33 + (lane & 31)] = a * sc * g[k0 + kk]; }
    LDS_WAIT(); asm volatile("" ::: "memory");
    const int c = lane & 7;
#pragma unroll
    for (int j = 0; j < 4; ++j) { const int nn = (lane >> 3) + 8 * j; const LAS float* s = scr + (8 * c) * 33 + nn;
        v4u o; o.x = pk2(s[0 * 33], s[1 * 33]); o.y = pk2(s[2 * 33], s[3 * 33]); o.z = pk2(s[4 * 33], s[5 * 33]); o.w = pk2(s[6 * 33], s[7 * 33]);
        *(GAS v4u*)(WT + (size_t)(n0 + nn) * DM + k0 + 8 * c) = o; }
    LDS_WAIT(); asm volatile("" ::: "memory");
}
__device__ __forceinline__ void row_norm_to_bf16(const float* xrow, bf16* orow, int lane) {
    const GAS f32x4* xr = (const GAS f32x4*)xrow + lane; f32x4 v[4]; float s = 0.f;
#pragma unroll
    for (int j = 0; j < 4; ++j) { v[j] = xr[64 * j]; s += (v[j].x * v[j].x + v[j].y * v[j].y) + (v[j].z * v[j].z + v[j].w * v[j].w); }
    const float rstd = 1.0f / sqrtf(wave_sum(s) * (1.f / DM) + RMS_EPS);
    GAS unsigned long long* o8 = (GAS unsigned long long*)orow + lane;
#pragma unroll
    for (int j = 0; j < 4; ++j) o8[64 * j] = (unsigned long long)pk2(v[j].x * rstd, v[j].y * rstd) | ((unsigned long long)pk2(v[j].z * rstd, v[j].w * rstd) << 32);
}
template <int MODE> __device__ __forceinline__ void row_res_norm(const float* base, const bf16* yrow, const float* g, float* xout, bf16* ob, int lane) {
    const GAS unsigned long long* yr = (const GAS unsigned long long*)yrow + lane; f32x4 y[4]; float s = 0.f;
#pragma unroll
    for (int j = 0; j < 4; ++j) { const unsigned long long w = yr[64 * j]; const unsigned lo = (unsigned)w, hi = (unsigned)(w >> 32);
        y[j].x = __builtin_bit_cast(float, lo << 16); y[j].y = __builtin_bit_cast(float, lo & 0xffff0000u); y[j].z = __builtin_bit_cast(float, hi << 16); y[j].w = __builtin_bit_cast(float, hi & 0xffff0000u);
        s += (y[j].x * y[j].x + y[j].y * y[j].y) + (y[j].z * y[j].z + y[j].w * y[j].w); }
    const float rstd = 1.0f / sqrtf(wave_sum(s) * (1.f / DM) + RMS_EPS);
    const GAS f32x4* br = (const GAS f32x4*)base + lane; const GAS f32x4* gr = (const GAS f32x4*)g + lane; GAS f32x4* xo = (GAS f32x4*)xout + lane; float s2 = 0.f;
#pragma unroll
    for (int j = 0; j < 4; ++j) { const f32x4 gg = gr[64 * j]; f32x4 x = br[64 * j]; x.x += y[j].x * rstd * gg.x; x.y += y[j].y * rstd * gg.y; x.z += y[j].z * rstd * gg.z; x.w += y[j].w * rstd * gg.w;
        xo[64 * j] = x; y[j] = x; s2 += (x.x * x.x + x.y * x.y) + (x.z * x.z + x.w * x.w); }
    const float r2 = (MODE == 0) ? 1.0f / sqrtf(wave_sum(s2) * (1.f / DM) + RMS_EPS) : 1.0f;
    GAS unsigned long long* o8 = (GAS unsigned long long*)ob + lane;
#pragma unroll
    for (int j = 0; j < 4; ++j) o8[64 * j] = (unsigned long long)pk2(y[j].x * r2, y[j].y * r2) | ((unsigned long long)pk2(y[j].z * r2, y[j].w * r2) << 32);
}
__device__ __forceinline__ int rel_bucket(int n) {
    if (n < 16) return n;
    const int large = 16 + (int)(logf((float)n / 16.f) / logf(8.f) * 16.f);
    return large < 31 ? large : 31;
}

struct Args { const float* in[17]; float* out; unsigned char* ws; int ph_lo, ph_hi; };
static_assert(sizeof(Args) == 17 * 8 + 8 + 8 + 8, "Args has no padding bytes");

__global__ void __launch_bounds__(NWAVES * 64, 2) mk_fwd(Args args) {
    extern __shared__ __attribute__((aligned(16))) unsigned char lds[];
    LAS unsigned char* L = (LAS unsigned char*)lds;
    volatile LAS unsigned* MISC = (volatile LAS unsigned*)(L + MISC_OFF);
    const int G = gridDim.x; const int bx = blockIdx.x; const int vcu = (G % 8 == 0) ? (bx % 8) * (G / 8) + bx / 8 : bx;
    unsigned char* ws = args.ws;
    gu32* ctl = (gu32*)(ws + WS_CTL);
    for (int u = threadIdx.x; u < (LDS_BYTES - LDSCTL_OFF) / 4; u += NWAVES * 64) ((LAS unsigned*)(L + LDSCTL_OFF))[u] = 0u;
    __syncthreads();
    XcdBarrier bar; bar.bar = (unsigned*)(ctl + CW_BAR); bar.x = 0; bar.st = nullptr;
    if (!MK_SPLIT) bar = xcd_barrier_post((unsigned*)(ctl + CW_BAR), MISC + 8);
    const int NGW = G * NWAVES;
#pragma unroll 1
    for (int ph = args.ph_lo; ph < args.ph_hi; ++ph) {
        float* out = args.out;
        int tid_op = threadIdx.x; asm volatile("" : "+v"(tid_op));
        const int tid = tid_op, lane = tid & 63, wave = __builtin_amdgcn_readfirstlane(tid >> 6); const int gw = vcu * NWAVES + wave;
        if (ph == 0) {
            const float* w_in = args.in[7]; const float* g_mix_pre = args.in[3]; const float* g_ffn_pre = args.in[5];
            LAS float* scr = (LAS float*)(L + RING_OFF + wave * 16384);
            constexpr int I_IN = (DM / 64) * (DIN / 32), I_OUT = (DM / 64) * (DM / 32), I_UP = (DM / 64) * (2 * DFF / 32), I_DOWN = (DFF / 64) * (DM / 32), I_G = I_OUT, I_PLE = (PLE / 64) * (DM / 32);
            constexpr int I_LAYER = I_IN + I_OUT + I_UP + I_DOWN + I_G + I_PLE;
#pragma unroll 1
            for (int it = gw; it < DEPTH * I_LAYER; it += NGW) {
                const int ly = it / I_LAYER; int r = it % I_LAYER;
                unsigned char* wb = ws + WS_W + (size_t)ly * W_LAYER;
                if (r < I_IN) { const int nblk = DIN / 32, kb = r / nblk, nb = r % nblk;
                    if (nb < 16) p0_pool_item(w_in + (size_t)ly * DM * DIN, args.in[8] + (size_t)ly * 4 * 128 * 128, args.in[9] + ly * 512, g_mix_pre + ly * DM, (bf16*)(wb + OFF_WIN), 32 * nb, 64 * kb, scr, lane);
                    else p0_transpose_item(w_in + (size_t)ly * DM * DIN, DIN, 32 * nb, g_mix_pre + ly * DM, DM, (bf16*)(wb + OFF_WIN), 32 * nb, 64 * kb, scr, lane);
                    continue; } r -= I_IN;
                const float* W; int ldw, srccol0, K, dstrow0, k0; const float* ks = nullptr; bf16* WT;
                if (r < I_OUT) { const int nblk = DM / 32, kb = r / nblk, nb = r % nblk; W = args.in[10] + (size_t)ly * DM * DM; ldw = DM; srccol0 = 32 * nb; K = DM; WT = (bf16*)(wb + OFF_WOUT); dstrow0 = 32 * nb; k0 = 64 * kb; }
                else if ((r -= I_OUT) < I_UP) { const int nblk = 2 * DFF / 32, kb = r / nblk, nb = r % nblk; const int R0 = 32 * nb, pn = R0 >> 8, bj = (R0 >> 7) & 1, i0 = R0 & 127;
                    W = args.in[11] + (size_t)ly * DM * 2 * DFF; ldw = 2 * DFF; srccol0 = bj * DFF + pn * 128 + i0; ks = g_ffn_pre + ly * DM; K = DM; WT = (bf16*)(wb + OFF_WUP); dstrow0 = R0; k0 = 64 * kb; }
                else if ((r -= I_UP) < I_DOWN) { const int nblk = DM / 32, kb = r / nblk, nb = r % nblk; W = args.in[14] + (size_t)ly * DFF * DM; ldw = DM; srccol0 = 32 * nb; K = DFF; WT = (bf16*)(wb + OFF_WDOWN); dstrow0 = 32 * nb; k0 = 64 * kb; }
                else if ((r -= I_DOWN) < I_G) { const int nblk = DM / 32, kb = r / nblk, nb = r % nblk; W = args.in[16] + (size_t)ly * DM * DM; ldw = DM; srccol0 = 32 * nb; K = DM; WT = (bf16*)(wb + OFF_WG); dstrow0 = 32 * nb; k0 = 64 * kb; }
                else { r -= I_G; const int nblk = DM / 32, kb = r / nblk, nb = r % nblk; W = args.in[15] + (size_t)ly * PLE * DM; ldw = DM; srccol0 = 32 * nb; K = PLE; WT = (bf16*)(wb + OFF_WPLE); dstrow0 = 32 * nb; k0 = 64 * kb; }
                p0_transpose_item(W, ldw, srccol0, ks, K, WT, dstrow0, k0, scr, lane);
            }
            { const float* p_in = args.in[1]; bf16* PB = (bf16*)(ws + WS_PB);
              const size_t n8 = (size_t)DEPTH * M * PLE / 8; const size_t gt = (size_t)vcu * (NWAVES * 64) + tid, GT = (size_t)G * NWAVES * 64;
              for (size_t i = gt; i < n8; i += GT) { const f32x4 a = ((const GAS f32x4*)p_in)[2 * i], b = ((const GAS f32x4*)p_in)[2 * i + 1];
                  v4u o; o.x = pk2(a.x, a.y); o.y = pk2(a.z, a.w); o.z = pk2(b.x, b.y); o.w = pk2(b.z, b.w); ((GAS v4u*)PB)[i] = o; } }
            { const float* x_in = args.in[0];
              for (int m = gw; m < M; m += NGW) row_norm_to_bf16(x_in + (size_t)m * DM, (bf16*)(ws + WS_HB0) + (size_t)m * DM, lane); }
            if (bx == 0) { const float* rel_bias = args.in[2]; float* lutg = (float*)(ws + WS_LUT);
                for (int i = tid; i < 8 * 128; i += NWAVES * 64) { const int h = i >> 7, d = i & 127; lutg[i] = rel_bias[rel_bucket(d) * NHEAD + h] * 1.4426950408889634f; } }
        } else {
            const int q = ph - 1, ly = q / 10, st = q - 10 * ly;
            unsigned char* wb = ws + WS_W + (size_t)ly * W_LAYER;
            bf16* HBa = (bf16*)(ws + ((ly & 1) ? WS_HB1 : WS_HB0));
            bf16* HBb = (bf16*)(ws + ((ly & 1) ? WS_HB0 : WS_HB1));
            bf16* EB = (bf16*)(ws + WS_E);
            if (st == 1) {
                const moba::bf16* PROJ = (const moba::bf16*)(ws + WS_PROJ); moba::bf16* CAT = (moba::bf16*)(ws + WS_CAT); const float* kms = (const float*)(ws + WS_KMS); const float* lutg = (const float*)(ws + WS_LUT);
                if (G == 256) { const int bh = vcu >> 2, s = vcu & 3;
#pragma unroll 1
                    for (int i = 0; i < 4; ++i) { const int j = (i == 0) ? 2 * s : (i == 1) ? 15 - 2 * s : (i == 2) ? 2 * s + 1 : 14 - 2 * s;
                        moba::moba_unit(bh >> 3, bh & 7, j, PROJ, CAT, kms, lutg, (char*)lds + RING_OFF); } }
                else {
#pragma unroll 1
                    for (int u = vcu; u < 1024; u += G) moba::moba_unit(u >> 7, (u >> 4) & 7, u & 15, PROJ, CAT, kms, lutg, (char*)lds + RING_OFF); }
            } else if (st == 3) {
                const float* xbase = (ly == 0) ? args.in[0] : out; const float* gp = args.in[4] + ly * DM;
#pragma unroll 1
                for (int m = gw; m < M; m += NGW) row_res_norm<0>(xbase + (size_t)m * DM, EB + (size_t)m * DM, gp, out + (size_t)m * DM, HBb + (size_t)m * DM, lane);
            } else if (st == 6) {
                const float* gp = args.in[6] + ly * DM;
#pragma unroll 1
                for (int m = gw; m < M; m += NGW) row_res_norm<1>(out + (size_t)m * DM, EB + (size_t)m * DM, gp, out + (size_t)m * DM, HBa + (size_t)m * DM, lane);
            } else if (st == 9) {
#pragma unroll 1
                for (int m = gw; m < M; m += NGW) row_norm_to_bf16(out + (size_t)m * DM, HBb + (size_t)m * DM, lane);
            } else {
                pg8::Gemm g; pg8::EpiAny E; E.mode = 0; E.O = EB; E.ldc = DM; E.kms = (float*)(ws + WS_KMS); E.cw = args.in[12] + (size_t)ly * 3 * DFF; E.cb = args.in[13] + (size_t)ly * DFF;
                E.sb = (float*)(ws + WS_SB); E.X = (LAS float*)(L + XCH_OFF); E.Xo = out; E.E = EB;
                g.M = M; g.N = DM; g.K = DM;
                if (st == 0) { g.A = HBa; g.Bt = (const bf16*)(wb + OFF_WIN); g.N = DIN; E.mode = 1; E.O = (bf16*)(ws + WS_PROJ); }
                else if (st == 2) { g.A = (const bf16*)(ws + WS_CAT); g.Bt = (const bf16*)(wb + OFF_WOUT); }
                else if (st == 4) { g.A = HBb; g.Bt = (const bf16*)(wb + OFF_WUP); g.N = 2 * DFF; E.mode = 2; E.O = (bf16*)(ws + WS_HID); }
                else if (st == 5) { g.A = (const bf16*)(ws + WS_HID); g.Bt = (const bf16*)(wb + OFF_WDOWN); g.K = DFF; }
                else if (st == 7) { g.A = (const bf16*)(ws + WS_PB) + (size_t)ly * M * PLE; g.Bt = (const bf16*)(wb + OFF_WPLE); g.K = PLE; }
                else { g.A = HBa; g.Bt = (const bf16*)(wb + OFF_WG); E.mode = 3; }
                pg8::StaticOrder S; S.init(M, g.N, G, bx);
                if (st == 5) {
                    bf16* HID = (bf16*)(ws + WS_HID); const float* sbuf = (const float*)(ws + WS_SB); pg8::Unit u;
#pragma unroll 1
                    for (int i = 0; S.next(i, u); ++i) { const int pm = u.pm; if ((pm & 15) == 0) continue;
#pragma unroll 1
                        for (int c = tid; c < DFF; c += NWAVES * 64) {
                            const float t2 = sbuf[(((size_t)(pm - 1) * 3 + 0) * 2 + 0) * DFF + c], t1 = sbuf[(((size_t)(pm - 1) * 3 + 0) * 2 + 1) * DFF + c];
                            const float g0 = sbuf[(((size_t)pm * 3 + 1) * 2 + 0) * DFF + c], g1 = sbuf[(((size_t)pm * 3 + 1) * 2 + 1) * DFF + c];
                            const float v0 = sbuf[(((size_t)pm * 3 + 2) * 2 + 0) * DFF + c], v1 = sbuf[(((size_t)pm * 3 + 2) * 2 + 1) * DFF + c];
                            const float w0 = E.cw[c], w1 = E.cw[DFF + c], w2 = E.cw[2 * DFF + c], b_ = E.cb[c];
                            const float c0 = b_ + w0 * t2 + w1 * t1 + w2 * g0, c1 = b_ + w0 * t1 + w1 * g0 + w2 * g1;
                            HID[(size_t)(pm * 256) * DFF + c] = (bf16)f2bf(pg8::gelu_tanh_f(c0) * v0); HID[(size_t)(pm * 256 + 1) * DFF + c] = (bf16)f2bf(pg8::gelu_tanh_f(c1) * v1); } }
                    VM_WAIT(); __syncthreads();
                }
                pg8::gemm_phase<pg8::EpiAny, pg8::StaticOrder, true, true>(L + RING_OFF, g, S, E);
            }
        }
        if (!MK_SPLIT && ph + 1 < args.ph_hi) xcd_barrier(bar);
    }
}
constexpr int N_PHASES = 1 + DEPTH * 10 - 1;

extern "C" void kernel_launch(void* const* d_in, const int* in_sizes, int n_in, void* d_out, int out_size, void* d_ws, size_t ws_size, hipStream_t stream) {
    static int grid = 0;
    if (grid == 0) {
        if (n_in != 17 || out_size != M * DM || ws_size < WS_END) { fprintf(stderr, "kernel_launch: unexpected shapes (n_in %d, out %d, ws %zu)\n", n_in, out_size, ws_size); grid = -1; return; }
        int dev = 0, cus = 0, per_cu = 0;
        if (hipGetDevice(&dev) != hipSuccess || hipDeviceGetAttribute(&cus, hipDeviceAttributeMultiprocessorCount, dev) != hipSuccess) { grid = -1; return; }
        if (hipFuncSetAttribute((const void*)mk_fwd, hipFuncAttributeMaxDynamicSharedMemorySize, LDS_BYTES) != hipSuccess) { fprintf(stderr, "kernel_launch: hipFuncSetAttribute failed\n"); grid = -1; return; }
        if (hipOccupancyMaxActiveBlocksPerMultiprocessor(&per_cu, (const void*)mk_fwd, NWAVES * 64, LDS_BYTES) != hipSuccess || per_cu < 1) { fprintf(stderr, "kernel_launch: occupancy query says %d blocks per CU\n", per_cu); (void)hipGetLastError(); }
        grid = cus;
    }
    if (grid < 0) return;
    (void)hipMemsetAsync((char*)d_ws + WS_CTL, 0, CTL_ZERO_BYTES, stream);
    Args a{};
    for (int i = 0; i < 17; ++i) a.in[i] = (const float*)d_in[i];
    a.out = (float*)d_out; a.ws = (unsigned char*)d_ws;
#if MK_SPLIT
    for (int p = 0; p < N_PHASES; ++p) { a.ph_lo = p; a.ph_hi = p + 1; hipLaunchKernelGGL(mk_fwd, dim3(grid), dim3(NWAVES * 64), LDS_BYTES, stream, a); }
#else
    a.ph_lo = 0; a.ph_hi = N_PHASES;
    void* kargs[] = {&a};
    hipError_t e = hipLaunchCooperativeKernel((const void*)mk_fwd, dim3(grid), dim3(NWAVES * 64), kargs, LDS_BYTES, stream);
    if (e != hipSuccess) { fprintf(stderr, "kernel_launch: cooperative launch failed: %s\n", hipGetErrorString(e)); }
#endif
}
```

```cpp
#include <hip/hip_runtime.h>
#include <hip/hip_bf16.h>
#include <cstdio>
#include <cstdint>
#include <cmath>
namespace pg8 {
#define PG8_LAS __attribute__((address_space(3)))
typedef unsigned short bf16_t;
typedef short bf16x8 __attribute__((ext_vector_type(8)));
typedef float f32x4 __attribute__((ext_vector_type(4)));
typedef unsigned u32x4 __attribute__((ext_vector_type(4)));
constexpr int BM = 256, BK = 64, HALF = 128, HTB = HALF * BK * 2  , STAGE_BYTES = 8 * HTB, NXCD = 8, WGM = 8;

__host__ __device__ __forceinline__ int lds_byte(int r, int c) { const int st = (r >> 4) * 2 + (c >> 5), rr = r & 15, cc = c & 31, ob = rr * 64 + cc * 2; return st * 1024 + (ob ^ (((ob >> 9) & 1) << 5)); }
__host__ __device__ __forceinline__ void stage_rc(int b, int& R, int& C) { const int st = b / 1024, sb = b % 1024, swz = sb ^ (((sb >> 9) & 1) << 5); R = (st >> 1) * 16 + swz / 64; C = (st & 1) * 32 + (swz % 64) / 2; }
__host__ __device__ __forceinline__ int perm32(int rho) { const int n = rho >> 4, i = rho & 15; return 8 * (i >> 2) + 4 * n + (i & 3); }

struct Unit { int pm, pn; };
struct Gemm { const bf16_t* A; const bf16_t* Bt; int M, N, K; };

struct StaticOrder {
    int nM, nN, nwg, G, c;
    __host__ __device__ void init(int M, int N, int G_, int c_) { nM = M / BM; nN = N / BM; nwg = nM * nN; G = G_; c = c_; }
    __host__ __device__ bool next(int i, Unit& u) const {
        const long L = (long)i * G + c; if (L >= nwg) return false;
        int wgid = (int)L; { const int q = nwg / NXCD, r = nwg % NXCD, xcd = wgid % NXCD, off = wgid / NXCD; wgid = (xcd < r ? xcd * (q + 1) : r * (q + 1) + (xcd - r) * q) + off; }
        const int nig = WGM * nN, gid = wgid / nig, fm = gid * WGM, gsz = (nM - fm) < WGM ? (nM - fm) : WGM;
        u.pm = fm + ((wgid % nig) % gsz); u.pn = (wgid % nig) / gsz; return true;
    }
    __device__ __forceinline__ void a_ready(const Unit&) const {}
    __device__ __forceinline__ void done(const Unit&) const {}
};
__device__ __forceinline__ unsigned cvt_pk_bf16(float lo, float hi) { unsigned r; asm volatile("v_cvt_pk_bf16_f32 %0, %1, %2" : "=v"(r) : "v"(lo), "v"(hi)); return r; }
typedef float f32x2 __attribute__((ext_vector_type(2)));
template <class Epi, class Sched, bool ALIGN_EPI = false, bool SP2 = false>
__device__ __forceinline__ void gemm_phase(PG8_LAS unsigned char* lds, const Gemm g, const Sched& S, const Epi& E) {
    int tid_op = threadIdx.x; asm volatile("" : "+v"(tid_op));
    const int tid = tid_op, wid = __builtin_amdgcn_readfirstlane(tid >> 6), lane = tid & 63, wr = wid >> 2, wc = wid & 3, fr = lane & 15, fq = lane >> 4;
    const int K = g.K, nt = K / BK;
    unsigned voffA[2], voffB[2];
#pragma unroll
    for (int i = 0; i < 2; ++i) { int R, C; stage_rc(tid * 16 + i * 8192, R, C); const int Rb = Epi::PERM ? ((R & ~31) + perm32(R & 31)) : R;
        voffA[i] = (unsigned)(R * K + C) * 2u; voffB[i] = (unsigned)(Rb * K + C) * 2u; }
    const size_t kstep = (size_t)(BK * 2);
    const size_t hstep = (size_t)HALF * K * 2;
    const size_t tstep = 2 * hstep;
    const unsigned ldsw = (unsigned)wid * 1024u;
    const int aoff = lds_byte(wr * 64 + fr, fq * 8), boff = lds_byte(wc * 32 + fr, fq * 8);
#define PG8_SA(b, h) (((b) * 2 + (h)) * HTB)
#define PG8_SB(b, h) ((4 + (b) * 2 + (h)) * HTB)
#define PG8_STAGE(bufoff, gbase, voff) do { _Pragma("unroll") for (int _i = 0; _i < 2; ++_i) \
        __builtin_amdgcn_global_load_lds((const unsigned*)((const char*)(gbase) + (voff)[_i]), (PG8_LAS unsigned*)(lds + (bufoff) + ldsw + _i * 8192), 16, 0, 0); } while (0)
#define PG8_LDA(dst, b, h) do { _Pragma("unroll") for (int m = 0; m < 4; ++m) _Pragma("unroll") for (int k = 0; k < 2; ++k) dst[m][k] = *(const PG8_LAS bf16x8*)(lds + PG8_SA(b, h) + aoff + m * 2048 + k * 1024); } while (0)
#define PG8_LDB(dst, b, h) do { _Pragma("unroll") for (int n = 0; n < 2; ++n) _Pragma("unroll") for (int k = 0; k < 2; ++k) dst[n][k] = *(const PG8_LAS bf16x8*)(lds + PG8_SB(b, h) + boff + n * 2048 + k * 1024); } while (0)
#define PG8_MMA(ai, bj, At, Bt) do { __builtin_amdgcn_s_setprio(1); _Pragma("unroll") for (int m = 0; m < 4; ++m) _Pragma("unroll") for (int n = 0; n < 2; ++n) _Pragma("unroll") for (int k = 0; k < 2; ++k) \
        acc[ai][bj][m][n] = __builtin_amdgcn_mfma_f32_16x16x32_bf16(Bt[n][k], At[m][k], acc[ai][bj][m][n], 0, 0, 0); __builtin_amdgcn_s_setprio(0); } while (0)
#define PG8_WAIT_V(n) asm volatile("s_waitcnt vmcnt(" #n ")" ::: "memory")
#define PG8_WAIT_L(n) asm volatile("s_waitcnt lgkmcnt(" #n ")" ::: "memory")
#define PG8_BAR __builtin_amdgcn_s_barrier()
#define PG8_SCHED __builtin_amdgcn_sched_barrier(0)
    Unit cur, nxt; int ui = 0;
    if (!S.next(0, cur)) return;
    f32x4 acc[2][2][4][2];
#pragma unroll
    for (int a = 0; a < 2; ++a)
#pragma unroll
        for (int b = 0; b < 2; ++b)
#pragma unroll
            for (int m = 0; m < 4; ++m)
#pragma unroll
                for (int n = 0; n < 2; ++n) acc[a][b][m][n] = (f32x4){0.f, 0.f, 0.f, 0.f};
    bf16x8 At[4][2], B0[2][2], B1[2][2];
    const char* cA = (const char*)g.A + (size_t)cur.pm * tstep; const char* cB = (const char*)g.Bt + (size_t)cur.pn * tstep;
    S.a_ready(cur);
    if constexpr (SP2) {
        PG8_STAGE(PG8_SB(0, 0), cB, voffB); PG8_STAGE(PG8_SB(0, 1), cB + hstep, voffB); PG8_STAGE(PG8_SA(0, 0), cA, voffA); PG8_STAGE(PG8_SA(0, 1), cA + hstep, voffA);
        if (wr == 1) PG8_BAR;
        PG8_WAIT_V(2); PG8_BAR;
        PG8_STAGE(PG8_SB(1, 0), cB + kstep, voffB); PG8_STAGE(PG8_SA(1, 0), cA + kstep, voffA); PG8_STAGE(PG8_SB(1, 1), cB + hstep + kstep, voffB);
        PG8_WAIT_V(6); PG8_BAR;
    } else {
        PG8_STAGE(PG8_SB(0, 0), cB, voffB); PG8_STAGE(PG8_SA(0, 0), cA, voffA); PG8_STAGE(PG8_SB(0, 1), cB + hstep, voffB); PG8_STAGE(PG8_SA(0, 1), cA + hstep, voffA);
        if (wr == 1) PG8_BAR;
        PG8_WAIT_V(4); PG8_BAR;
        PG8_STAGE(PG8_SB(1, 0), cB + kstep, voffB); PG8_STAGE(PG8_SA(1, 0), cA + kstep, voffA); PG8_STAGE(PG8_SB(1, 1), cB + hstep + kstep, voffB);
        PG8_WAIT_V(6); PG8_BAR;
    }
    for (;;) {
        const bool has_next = S.next(ui + 1, nxt);
        const char* nA = has_next ? (const char*)g.A + (size_t)nxt.pm * tstep : cA; const char* nB = has_next ? (const char*)g.Bt + (size_t)nxt.pn * tstep : cB;
        for (int t = 0; t < nt; t += 2) {
            const bool last = (t == nt - 2);
            const char* a1 = cA + (size_t)(t + 1) * kstep;
            const char* a2 = last ? nA : cA + (size_t)(t + 2) * kstep; const char* b2 = last ? nB : cB + (size_t)(t + 2) * kstep;
            const char* a3 = a2 + kstep; const char* b3 = b2 + kstep;
            if (last && has_next) S.a_ready(nxt);
            if constexpr (SP2) {
            PG8_LDB(B0, 0, 0); PG8_LDB(B1, 0, 1); PG8_SCHED; PG8_LDA(At, 0, 0); PG8_STAGE(PG8_SA(1, 1), a1 + hstep, voffA);
            PG8_WAIT_V(8); PG8_WAIT_L(0); PG8_BAR; PG8_MMA(0, 0, At, B0); PG8_MMA(0, 1, At, B1); PG8_BAR; PG8_SCHED;
            PG8_LDA(At, 0, 1); PG8_STAGE(PG8_SB(0, 0), b2, voffB); PG8_STAGE(PG8_SB(0, 1), b2 + hstep, voffB); PG8_STAGE(PG8_SA(0, 0), a2, voffA);
            PG8_WAIT_V(8); PG8_WAIT_L(0); PG8_BAR; PG8_MMA(1, 0, At, B0); PG8_MMA(1, 1, At, B1); PG8_BAR; PG8_SCHED;
            PG8_LDB(B0, 1, 0); PG8_LDB(B1, 1, 1); PG8_SCHED; PG8_LDA(At, 1, 0); PG8_STAGE(PG8_SA(0, 1), a2 + hstep, voffA);
            PG8_WAIT_V(8); PG8_WAIT_L(0); PG8_BAR; PG8_MMA(0, 0, At, B0); PG8_MMA(0, 1, At, B1); PG8_BAR; PG8_SCHED;
            PG8_LDA(At, 1, 1); PG8_STAGE(PG8_SB(1, 0), b3, voffB); PG8_STAGE(PG8_SB(1, 1), b3 + hstep, voffB); PG8_STAGE(PG8_SA(1, 0), a3, voffA);
            PG8_WAIT_V(8); PG8_WAIT_L(0); PG8_BAR; PG8_MMA(1, 0, At, B0); PG8_MMA(1, 1, At, B1); PG8_BAR; PG8_SCHED;
            } else {
            PG8_LDB(B0, 0, 0); PG8_SCHED; PG8_LDA(At, 0, 0); PG8_STAGE(PG8_SA(1, 1), a1 + hstep, voffA);
            PG8_WAIT_L(8); PG8_BAR; PG8_WAIT_L(0); PG8_MMA(0, 0, At, B0); PG8_BAR; PG8_SCHED;
            PG8_LDB(B1, 0, 1); PG8_STAGE(PG8_SB(0, 0), b2, voffB);
            PG8_BAR; PG8_WAIT_L(0); PG8_MMA(0, 1, At, B1); PG8_BAR;
            PG8_LDA(At, 0, 1); PG8_STAGE(PG8_SA(0, 0), a2, voffA);
            PG8_BAR; PG8_WAIT_L(0); PG8_MMA(1, 0, At, B0); PG8_BAR; PG8_SCHED;
            PG8_STAGE(PG8_SB(0, 1), b2 + hstep, voffB);
            PG8_WAIT_V(6); PG8_BAR; PG8_MMA(1, 1, At, B1); PG8_BAR;
            PG8_LDB(B0, 1, 0); PG8_SCHED; PG8_LDA(At, 1, 0); PG8_STAGE(PG8_SA(0, 1), a2 + hstep, voffA);
            PG8_WAIT_L(8); PG8_BAR; PG8_WAIT_L(0); PG8_MMA(0, 0, At, B0); PG8_BAR; PG8_SCHED;
            PG8_LDB(B1, 1, 1); PG8_STAGE(PG8_SB(1, 0), b3, voffB);
            PG8_BAR; PG8_WAIT_L(0); PG8_MMA(0, 1, At, B1); PG8_BAR;
            PG8_LDA(At, 1, 1); PG8_STAGE(PG8_SA(1, 0), a3, voffA);
            PG8_BAR; PG8_WAIT_L(0); PG8_MMA(1, 0, At, B0); PG8_BAR; PG8_SCHED;
            PG8_STAGE(PG8_SB(1, 1), b3 + hstep, voffB);
            PG8_WAIT_V(6); PG8_BAR; PG8_MMA(1, 1, At, B1); PG8_BAR;
            }
        }
        if constexpr (ALIGN_EPI) { if (wr == 0) PG8_BAR; }
        if constexpr (!Epi::AFTER_DRAIN) { E(acc, cur, wr, wc, fr, fq); S.done(cur); }
        if (!has_next) break;
#pragma unroll
        for (int a = 0; a < 2; ++a)
#pragma unroll
            for (int b = 0; b < 2; ++b)
#pragma unroll
                for (int m = 0; m < 4; ++m)
#pragma unroll
                    for (int n = 0; n < 2; ++n) acc[a][b][m][n] = (f32x4){0.f, 0.f, 0.f, 0.f};
        cur = nxt; cA = nA; cB = nB; ++ui;
        if constexpr (ALIGN_EPI) { if (wr == 1) PG8_BAR; }
    }
    PG8_WAIT_V(0);
    if constexpr (!ALIGN_EPI) { if (wr == 0) PG8_BAR; }
    PG8_BAR;
    if constexpr (Epi::AFTER_DRAIN) { E.fused(acc, cur, wr, wc, fr, fq, lds, wid, lane); S.done(cur); }
#undef PG8_SA
#undef PG8_SB
#undef PG8_STAGE
#undef PG8_LDA
#undef PG8_LDB
#undef PG8_MMA
#undef PG8_WAIT_V
#undef PG8_WAIT_L
#undef PG8_BAR
#undef PG8_SCHED
}
}
namespace pg8 {
constexpr float QSCALE = 0.125f * 1.4426950408889634f;
template <int CTRL> __device__ __forceinline__ float dpp_mov(float old, float src) {
    return __builtin_bit_cast(float, __builtin_amdgcn_update_dpp(__builtin_bit_cast(int, old), __builtin_bit_cast(int, src), CTRL, 0xf, 0xf, false));
}
struct EpiStoreBf16 {
    static constexpr bool PERM = true, AFTER_DRAIN = false;
    bf16_t* O; int ldc;
    __device__ __forceinline__ void operator()(const f32x4 (&acc)[2][2][4][2], const Unit& u, int wr, int wc, int fr, int fq) const {
        const int row0 = u.pm * BM + wr * 64 + fr, col0 = u.pn * BM + wc * 32 + 8 * fq;
#pragma unroll
        for (int ai = 0; ai < 2; ++ai)
#pragma unroll
            for (int m = 0; m < 4; ++m) { bf16_t* rowp = O + (size_t)(row0 + ai * HALF + m * 16) * ldc + col0;
#pragma unroll
                for (int bj = 0; bj < 2; ++bj) { const f32x4 v0 = acc[ai][bj][m][0], v1 = acc[ai][bj][m][1];
                    u32x4 w; w.x = cvt_pk_bf16(v0[0], v0[1]); w.y = cvt_pk_bf16(v0[2], v0[3]); w.z = cvt_pk_bf16(v1[0], v1[1]); w.w = cvt_pk_bf16(v1[2], v1[3]);
                    *(u32x4*)(rowp + bj * HALF) = w; } }
    }
};
struct EpiIn {
    static constexpr bool PERM = true, AFTER_DRAIN = false;
    bf16_t* O; float* kms;
    __device__ __forceinline__ void operator()(const f32x4 (&acc)[2][2][4][2], const Unit& u, int wr, int wc, int fr, int fq) const {
        const int row0 = u.pm * BM + wr * 64 + fr, col0 = u.pn * BM + wc * 32 + 8 * fq;
        const float sc = (u.pn == 2 || u.pn == 3) ? QSCALE : 1.f;
#pragma unroll
        for (int ai = 0; ai < 2; ++ai)
#pragma unroll
            for (int m = 0; m < 4; ++m) { bf16_t* rowp = O + (size_t)(row0 + ai * HALF + m * 16) * 2048 + col0;
#pragma unroll
                for (int bj = 0; bj < 2; ++bj) { const f32x4 v0 = acc[ai][bj][m][0] * sc, v1 = acc[ai][bj][m][1] * sc;
                    u32x4 w; w.x = cvt_pk_bf16(v0[0], v0[1]); w.y = cvt_pk_bf16(v0[2], v0[3]); w.z = cvt_pk_bf16(v1[0], v1[1]); w.w = cvt_pk_bf16(v1[2], v1[3]);
                    *(u32x4*)(rowp + bj * HALF) = w; } }
        if (u.pn == 4 || u.pn == 5) {
#pragma unroll
            for (int bj = 0; bj < 2; ++bj)
#pragma unroll
                for (int n = 0; n < 2; ++n) {
                    f32x4 s = acc[0][bj][0][n];
#pragma unroll
                    for (int m = 1; m < 4; ++m) s += acc[0][bj][m][n];
#pragma unroll
                    for (int m = 0; m < 4; ++m) s += acc[1][bj][m][n];
#pragma unroll
                    for (int o = 1; o < 16; o <<= 1) { s[0] += __shfl_xor(s[0], o); s[1] += __shfl_xor(s[1], o); s[2] += __shfl_xor(s[2], o); s[3] += __shfl_xor(s[3], o); }
                    if (fr == 0) *(f32x4*)(kms + ((size_t)u.pm * 2 + wr) * 512 + (u.pn - 4) * 256 + bj * HALF + wc * 32 + 8 * fq + 4 * n) = s;
                }
        }
    }
};
__device__ __forceinline__ float gelu_tanh_f(float c) {
    const float z = c * (-2.3022081981f + (-0.10294324f) * (c * c));
    return c * __builtin_amdgcn_rcpf(1.0f + __builtin_amdgcn_exp2f(z));
}
struct EpiUp {
    static constexpr bool PERM = true, AFTER_DRAIN = false;
    bf16_t* H; const float* cw; const float* cb; float* sb; PG8_LAS float* X;
    __device__ __forceinline__ void operator()(const f32x4 (&acc)[2][2][4][2], const Unit& u, int wr, int wc, int fr, int fq) const {
        const int lc0 = wc * 32 + 8 * fq, hc0 = u.pn * 128 + lc0;
        f32x4 w0[2], w1[2], w2[2], bb[2];
#pragma unroll
        for (int n = 0; n < 2; ++n) { w0[n] = *(const f32x4*)(cw + hc0 + 4 * n); w1[n] = *(const f32x4*)(cw + 2816 + hc0 + 4 * n); w2[n] = *(const f32x4*)(cw + 2 * 2816 + hc0 + 4 * n); bb[n] = *(const f32x4*)(cb + hc0 + 4 * n); }
        if (fr >= 14) {
#pragma unroll
            for (int ai = 0; ai < 2; ++ai)
#pragma unroll
                for (int n = 0; n < 2; ++n) *(PG8_LAS f32x4*)(X + ((2 * ai + wr) * 2 + (fr - 14)) * 128 + lc0 + 4 * n) = acc[ai][0][3][n];
            if (wr == 1) {
#pragma unroll
                for (int n = 0; n < 2; ++n) *(f32x4*)(sb + (((size_t)u.pm * 3 + 0) * 2 + (fr - 14)) * 2816 + hc0 + 4 * n) = acc[1][0][3][n];
            }
        }
        if (fr < 2 && wr == 0) {
#pragma unroll
            for (int n = 0; n < 2; ++n) { *(f32x4*)(sb + (((size_t)u.pm * 3 + 1) * 2 + fr) * 2816 + hc0 + 4 * n) = acc[0][0][0][n];
                                          *(f32x4*)(sb + (((size_t)u.pm * 3 + 2) * 2 + fr) * 2816 + hc0 + 4 * n) = acc[0][1][0][n]; }
        }
        asm volatile("s_waitcnt lgkmcnt(0)" ::: "memory"); __builtin_amdgcn_s_barrier(); asm volatile("" ::: "memory");
#pragma unroll
        for (int ai = 0; ai < 2; ++ai) {
            const int g = 2 * ai + wr;
            f32x4 hh[2] = {(f32x4){0.f, 0.f, 0.f, 0.f}, (f32x4){0.f, 0.f, 0.f, 0.f}};
            if (g > 0 && fr >= 14) {
#pragma unroll
                for (int n = 0; n < 2; ++n) hh[n] = *(const PG8_LAS f32x4*)(X + ((g - 1) * 2 + (fr - 14)) * 128 + lc0 + 4 * n);
            }
#pragma unroll
            for (int m = 0; m < 4; ++m) {
                float o[8];
#pragma unroll
                for (int n = 0; n < 2; ++n)
#pragma unroll
                    for (int e = 0; e < 4; ++e) {
                        const float cur = acc[ai][0][m][n][e];
                        const float prv = (m == 0) ? hh[n][e] : acc[ai][0][m == 0 ? 0 : m - 1][n][e];
                        const float t1 = dpp_mov<0x121>(prv, prv);
                        const float p1 = dpp_mov<0x111>(t1, cur);
                        const float t2 = dpp_mov<0x122>(prv, prv);
                        const float p2 = dpp_mov<0x112>(t2, cur);
                        const float c = bb[n][e] + w0[n][e] * p2 + w1[n][e] * p1 + w2[n][e] * cur;
                        o[4 * n + e] = gelu_tanh_f(c) * acc[ai][1][m][n][e];
                    }
                u32x4 w; w.x = cvt_pk_bf16(o[0], o[1]); w.y = cvt_pk_bf16(o[2], o[3]); w.z = cvt_pk_bf16(o[4], o[5]); w.w = cvt_pk_bf16(o[6], o[7]);
                *(u32x4*)(H + (size_t)(u.pm * BM + ai * HALF + wr * 64 + m * 16 + fr) * 2816 + hc0) = w;
            }
        }
    }
};
struct EpiPle {
    static constexpr bool PERM = true, AFTER_DRAIN = false;
    float* Xo; const bf16_t* E;
    __device__ __forceinline__ void operator()(const f32x4 (&acc)[2][2][4][2], const Unit& u, int wr, int wc, int fr, int fq) const {
        const int col0 = u.pn * BM + wc * 32 + 8 * fq;
#pragma unroll
        for (int ai = 0; ai < 2; ++ai)
#pragma unroll
            for (int m = 0; m < 4; ++m) { const size_t off = (size_t)(u.pm * BM + ai * HALF + wr * 64 + m * 16 + fr) * 1024 + col0;
#pragma unroll
                for (int bj = 0; bj < 2; ++bj) { const size_t o2 = off + bj * HALF; const u32x4 ev = *(const u32x4*)(E + o2);
#pragma unroll
                    for (int n = 0; n < 2; ++n) { f32x4 xv = *(const f32x4*)(Xo + o2 + 4 * n); const f32x4 a = acc[ai][bj][m][n];
                        const unsigned ea = n == 0 ? ev.x : ev.z, eb = n == 0 ? ev.y : ev.w;
                        const float e0 = __builtin_bit_cast(float, ea << 16), e1 = __builtin_bit_cast(float, ea & 0xffff0000u), e2 = __builtin_bit_cast(float, eb << 16), e3 = __builtin_bit_cast(float, eb & 0xffff0000u);
                        xv[0] += e0 * __builtin_amdgcn_rcpf(1.0f + __builtin_amdgcn_exp2f(-1.4426950408889634f * a[0]));
                        xv[1] += e1 * __builtin_amdgcn_rcpf(1.0f + __builtin_amdgcn_exp2f(-1.4426950408889634f * a[1]));
                        xv[2] += e2 * __builtin_amdgcn_rcpf(1.0f + __builtin_amdgcn_exp2f(-1.4426950408889634f * a[2]));
                        xv[3] += e3 * __builtin_amdgcn_rcpf(1.0f + __builtin_amdgcn_exp2f(-1.4426950408889634f * a[3]));
                        *(f32x4*)(Xo + o2 + 4 * n) = xv; } } }
    }
};
struct EpiAny {
    static constexpr bool PERM = true, AFTER_DRAIN = false;
    int mode;
    bf16_t* O; int ldc; float* kms; const float* cw; const float* cb; float* sb; PG8_LAS float* X; float* Xo; const bf16_t* E;
    __device__ __forceinline__ void operator()(const f32x4 (&acc)[2][2][4][2], const Unit& u, int wr, int wc, int fr, int fq) const {
        asm volatile("" : "+v"(fr), "+v"(fq));
        if (mode == 0) { EpiStoreBf16 e{O, ldc}; e(acc, u, wr, wc, fr, fq); }
        else if (mode == 1) { EpiIn e{O, kms}; e(acc, u, wr, wc, fr, fq); }
        else if (mode == 2) { EpiUp e{O, cw, cb, sb, X}; e(acc, u, wr, wc, fr, fq); }
        else { EpiPle e{Xo, E}; e(acc, u, wr, wc, fr, fq); }
    }
};
}
namespace moba {
using bf16 = __hip_bfloat16;
using bf16x8 = __attribute__((ext_vector_type(8))) short;
using s16x4 = __attribute__((ext_vector_type(4))) short;
using f32x16 = __attribute__((ext_vector_type(16))) float;
using f32x4 = __attribute__((ext_vector_type(4))) float;
using u32x4 = __attribute__((ext_vector_type(4))) unsigned;
constexpr int SEQ = 4096, NHEAD = 8, PQ = 2048  , PO = 1024  ;
constexpr int SLOTB = 8192, LDS_K = 0, LDS_V = 3 * SLOTB, LDS_WS = 6 * SLOTB, LDS_OST = LDS_WS + 8 * 256, LDS_LUT = LDS_OST + 8 * 4096, LDS_KM = LDS_LUT + 512, LDS_SLAB = LDS_KM + 4096, LDS_END = LDS_SLAB + 271 * 128;
static_assert(LDS_END <= 131072, "moba LDS map");
__device__ __forceinline__ int crow(int r, int hi) { return (r & 3) + 8 * (r >> 2) + 4 * hi; }
#define SBAR() __builtin_amdgcn_sched_barrier(0)
__device__ __forceinline__ void glds16(const void* gsrc, unsigned lds_dst) { unsigned keep;
    asm volatile("s_mov_b32 %0, m0\n\ts_mov_b32 m0, %2\n\ts_nop 0\n\tglobal_load_lds_dwordx4 %1, off\n\ts_mov_b32 m0, %0" : "=&s"(keep) : "v"(gsrc), "s"(lds_dst) : "memory"); }
__device__ __forceinline__ float max3f(float a, float b, float c) { float r; asm("v_max3_f32 %0, %1, %2, %3" : "=v"(r) : "v"(a), "v"(b), "v"(c)); return r; }
__device__ __forceinline__ float max2f(float a, float b) { float r; asm("v_max_f32_e32 %0, %1, %2" : "=v"(r) : "v"(a), "v"(b)); return r; }
typedef float f32x2_t __attribute__((ext_vector_type(2))); typedef __bf16 bf16x2_t __attribute__((ext_vector_type(2)));
__device__ __forceinline__ unsigned cvtpk_s(float lo, float hi) { f32x2_t v = {lo, hi}; bf16x2_t b = __builtin_convertvector(v, bf16x2_t); return __builtin_bit_cast(unsigned, b); }
__device__ __forceinline__ void qkt(f32x16& p0, f32x16& p1, const char* Kslot, const bf16x8* qr, const f32x16& negm, int r32, int hi) {
    const char* kb = Kslot + hi * 1024 + r32 * 16;
#pragma unroll
    for (int d0 = 0; d0 < 4; ++d0) {
        const bf16x8 b0 = *reinterpret_cast<const bf16x8*>(kb + d0 * 2048);
        const bf16x8 b1 = *reinterpret_cast<const bf16x8*>(kb + d0 * 2048 + 512);
        if (d0 == 0) { p0 = __builtin_amdgcn_mfma_f32_32x32x16_bf16(b0, qr[0], negm, 0, 0, 0); p1 = __builtin_amdgcn_mfma_f32_32x32x16_bf16(b1, qr[0], negm, 0, 0, 0); }
        else { p0 = __builtin_amdgcn_mfma_f32_32x32x16_bf16(b0, qr[d0], p0, 0, 0, 0); p1 = __builtin_amdgcn_mfma_f32_32x32x16_bf16(b1, qr[d0], p1, 0, 0, 0); } }
}
__device__ __forceinline__ float rowmax(const f32x16& p0, const f32x16& p1) {
    float a = max3f(p0[0], p0[1], p1[0]), b = max3f(p0[2], p0[3], p1[1]); a = max3f(a, p1[2], p1[3]);
#pragma unroll
    for (int r = 4; r < 16; r += 4) { a = max3f(a, p0[r], p0[r + 1]); b = max3f(b, p0[r + 2], p0[r + 3]); a = max3f(a, p1[r], p1[r + 1]); b = max3f(b, p1[r + 2], p1[r + 3]); }
    const float m = max2f(a, b);
    auto rr = __builtin_amdgcn_permlane32_swap(__float_as_uint(m), __float_as_uint(m), false, false);
    return max2f(__uint_as_float(rr[0]), __uint_as_float(rr[1]));
}
__device__ __forceinline__ void pv(f32x16* o, int vb, bf16x8 pa0, bf16x8 pa1, bf16x8 pa2, bf16x8 pa3) {
#pragma unroll
    for (int d0 = 0; d0 < 2; ++d0) { s16x4 lo[4], hi[4];
#pragma unroll
        for (int ks = 0; ks < 4; ++ks) {
            asm volatile("ds_read_b64_tr_b16 %0,%1 offset:%c2" : "=&v"(lo[ks]) : "v"(vb), "i"(d0 * 4096 + ks * 1024) : "memory");
            asm volatile("ds_read_b64_tr_b16 %0,%1 offset:%c2" : "=&v"(hi[ks]) : "v"(vb), "i"(d0 * 4096 + ks * 1024 + 512) : "memory"); }
        asm volatile("s_waitcnt lgkmcnt(0)" ::: "memory"); SBAR();
#define PK(k) (bf16x8){lo[k][0], lo[k][1], lo[k][2], lo[k][3], hi[k][0], hi[k][1], hi[k][2], hi[k][3]}
        o[d0] = __builtin_amdgcn_mfma_f32_32x32x16_bf16(pa0, PK(0), o[d0], 0, 0, 0);
        o[d0] = __builtin_amdgcn_mfma_f32_32x32x16_bf16(pa1, PK(1), o[d0], 0, 0, 0);
        o[d0] = __builtin_amdgcn_mfma_f32_32x32x16_bf16(pa2, PK(2), o[d0], 0, 0, 0);
        o[d0] = __builtin_amdgcn_mfma_f32_32x32x16_bf16(pa3, PK(3), o[d0], 0, 0, 0);
#undef PK
    }
}
__device__ __forceinline__ float bf_lo(unsigned w) { return __builtin_bit_cast(float, w << 16); }
__device__ __forceinline__ float bf_hi(unsigned w) { return __builtin_bit_cast(float, w & 0xffff0000u); }

__device__ __forceinline__ void moba_unit(int b, int h, int j, const bf16* proj, bf16* concat, const float* kms, const float* lutg, char* shm) {
    int tid_op = threadIdx.x; asm volatile("" : "+v"(tid_op));
    const int tid = tid_op, lane = tid & 63, r32 = lane & 31, hi = lane >> 5; const int wid = __builtin_amdgcn_readfirstlane(tid >> 6);
    const long rowbase = (long)b * SEQ; const int q0 = j * 256;
    float* lut = (float*)(shm + LDS_LUT); float* km = (float*)(shm + LDS_KM);
    for (int i = tid; i < 271 * 8; i += 512) { const int sr = i >> 3, oc = i & 7, rr = q0 - 15 + sr;
        if (rr >= 0) { const u32x4 v = *(const u32x4*)(proj + (rowbase + rr) * PQ + 64 * h + oc * 8); *(u32x4*)(shm + LDS_SLAB + sr * 128 + oc * 16) = v; } }
    for (int i = tid; i < j * 64; i += 512) { const int n = i >> 6, d = i & 63; const float* kp = kms + ((size_t)(16 * b + n) * 2) * 512 + 64 * h + d; km[i] = (kp[0] + kp[512]) * (1.0f / 256.0f); }
    if (tid < 128) lut[tid] = lutg[h * 128 + tid];
    __syncthreads();
    { const int oc = tid & 7, rg = tid >> 3; const int w = 2 << (h >> 1);
#pragma unroll
      for (int r = 0; r < 4; ++r) { const int lr = 4 * rg + r, t = q0 + lr; const int cnt = (t + 1 < w) ? (t + 1) : w;
        float s[8];
#pragma unroll
        for (int e = 0; e < 8; ++e) s[e] = 0.f;
        for (int i = 0; i < cnt; ++i) { const u32x4 v = *(const u32x4*)(shm + LDS_SLAB + (lr + 15 - i) * 128 + oc * 16);
            s[0] += bf_lo(v.x); s[1] += bf_hi(v.x); s[2] += bf_lo(v.y); s[3] += bf_hi(v.y); s[4] += bf_lo(v.z); s[5] += bf_hi(v.z); s[6] += bf_lo(v.w); s[7] += bf_hi(v.w); }
        const u32x4 c = *(const u32x4*)(shm + LDS_SLAB + (lr + 15) * 128 + oc * 16); const float ic = 1.0f / (float)cnt;
        u32x4 o; o.x = cvtpk_s(s[0] * ic - bf_lo(c.x), s[1] * ic - bf_hi(c.x)); o.y = cvtpk_s(s[2] * ic - bf_lo(c.y), s[3] * ic - bf_hi(c.y));
        o.z = cvtpk_s(s[4] * ic - bf_lo(c.z), s[5] * ic - bf_hi(c.z)); o.w = cvtpk_s(s[6] * ic - bf_lo(c.w), s[7] * ic - bf_hi(c.w));
        *(u32x4*)(concat + (rowbase + t) * PO + 64 * h + oc * 8) = o; } }
    const bf16* Qw = proj + (rowbase + q0 + wid * 32) * PQ + 512 + h * 64;
    const bf16* Kh = proj + rowbase * PQ + 1024 + h * 64; const bf16* Vh = proj + rowbase * PQ + 1536 + h * 64;
    const unsigned lds0 = (unsigned)(uintptr_t)shm;
    float* wsf = (float*)(shm + LDS_WS) + wid * 64;
    const bf16* ksrc = Kh + (long)lane * PQ + wid * 8;
    const bf16* vsrc = Vh + (long)(16 * (wid & 3) + (lane >> 2)) * PQ + (wid >> 2) * 32 + (lane & 3) * 8;
    const unsigned kdst = lds0 + LDS_K + wid * 1024, vdst = lds0 + LDS_V + wid * 1024;
    const int vb0 = (int)(lds0 + LDS_V) + ((lane >> 4) & 1) * 32 + (lane & 3) * 8 + (4 * hi + ((lane & 15) >> 2)) * 64;
#define KROW(t) ((t) < 4 ? q0 + 64 * (t) : (j - 1 - (((t) - 4) >> 2)) * 256 + 64 * (((t) - 4) & 3))
#define DMA_KV(t, slot) do { const long kr_ = KROW(t); glds16(ksrc + kr_ * PQ, (unsigned)__builtin_amdgcn_readfirstlane(kdst + (slot))); glds16(vsrc + kr_ * PQ, (unsigned)__builtin_amdgcn_readfirstlane(vdst + (slot))); } while (0)
    const int NT = 4 * (j + 1);
    DMA_KV(0, 0);
    bf16x8 qr[4];
#pragma unroll
    for (int d0 = 0; d0 < 4; ++d0) qr[d0] = *reinterpret_cast<const bf16x8*>(&Qw[(long)r32 * PQ + d0 * 16 + hi * 8]);
    unsigned selmask = 0u;
    {
        float v1 = -INFINITY, v2 = -INFINITY, v3 = -INFINITY; int i1 = -1, i2 = -1, i3 = -1;
        u32x4 qw[4];
#pragma unroll
        for (int d0 = 0; d0 < 4; ++d0) qw[d0] = __builtin_bit_cast(u32x4, qr[d0]);
#pragma unroll 1
        for (int n = 0; n < j; ++n) {
            float a = 0.f;
#pragma unroll
            for (int d0 = 0; d0 < 4; ++d0) { const f32x4 k0 = *(const f32x4*)(km + n * 64 + 16 * d0 + 8 * hi), k1 = *(const f32x4*)(km + n * 64 + 16 * d0 + 8 * hi + 4);
                a += bf_lo(qw[d0].x) * k0[0] + bf_hi(qw[d0].x) * k0[1] + bf_lo(qw[d0].y) * k0[2] + bf_hi(qw[d0].y) * k0[3] + bf_lo(qw[d0].z) * k1[0] + bf_hi(qw[d0].z) * k1[1] + bf_lo(qw[d0].w) * k1[2] + bf_hi(qw[d0].w) * k1[3]; }
            a += __shfl_xor(a, 32);
            if (a > v1) { v3 = v2; i3 = i2; v2 = v1; i2 = i1; v1 = a; i1 = n; }
            else if (a > v2) { v3 = v2; i3 = i2; v2 = a; i2 = n; }
            else if (a > v3) { v3 = a; i3 = n; }
        }
        if (i1 >= 0) selmask |= 1u << i1;
        if (i2 >= 0) selmask |= 1u << i2;
        if (i3 >= 0) selmask |= 1u << i3;
    }
    float m_run = -INFINITY, l_reg = 0.f; f32x16 o[2]; o[0] = f32x16{}; o[1] = f32x16{}; f32x16 zero16 = f32x16{};
    const int qrel = wid * 32 + r32;
    for (int t = 0; t < NT; ++t) {
        const int slot = (t & 1) * SLOTB;
        asm volatile("s_waitcnt vmcnt(0) lgkmcnt(0)\n\ts_barrier" ::: "memory");
        if (t + 1 < NT) DMA_KV(t + 1, slot ^ SLOTB);
        const bool own = t < 4; const int blk = own ? j : j - 1 - ((t - 4) >> 2); const int kt = own ? t : ((t - 4) & 3);
        const bool rowsel = ((selmask >> blk) & 1u) != 0u;
        const bool active = own ? (64 * kt <= 32 * wid + 31) : (__ballot(rowsel) != 0ull);
        if (active) {
            f32x16 p0, p1; qkt(p0, p1, shm + LDS_K + slot, qr, zero16, r32, hi);
            if (own || blk == j - 1) {
                const int dbase = (own ? qrel : qrel + 256) - 64 * kt - 4 * hi;
                const bool keep = own || rowsel;
#pragma unroll
                for (int r = 0; r < 16; ++r) { const int d0_ = dbase - ((r & 3) + 8 * (r >> 2)), d1_ = d0_ - 32;
                    const float b0 = lut[d0_ < 0 ? 0 : (d0_ > 127 ? 127 : d0_)], b1 = lut[d1_ < 0 ? 0 : (d1_ > 127 ? 127 : d1_)];
                    p0[r] = (keep && d0_ >= 0) ? p0[r] + b0 : -INFINITY; p1[r] = (keep && d1_ >= 0) ? p1[r] + b1 : -INFINITY; }
            } else {
                const float bc = lut[127];
#pragma unroll
                for (int r = 0; r < 16; ++r) { p0[r] = rowsel ? p0[r] + bc : -INFINITY; p1[r] = rowsel ? p1[r] + bc : -INFINITY; }
            }
            const float rm = rowmax(p0, p1);
            const float mnew = fmaxf(m_run, rm);
            const float alpha = __builtin_amdgcn_exp2f(m_run - mnew);
            if (__any(mnew > m_run)) {
                if (hi == 0) wsf[r32] = alpha;
                asm volatile("s_waitcnt lgkmcnt(0)" ::: "memory");
#pragma unroll
                for (int d_ = 0; d_ < 2; ++d_)
#pragma unroll
                    for (int r = 0; r < 16; ++r) o[d_][r] *= wsf[crow(r, hi)];
            }
            m_run = mnew;
            float sacc = 0.f;
#pragma unroll
            for (int r = 0; r < 16; ++r) { p0[r] = __builtin_amdgcn_exp2f(p0[r] - mnew); p1[r] = __builtin_amdgcn_exp2f(p1[r] - mnew); sacc += p0[r] + p1[r]; }
            l_reg = l_reg * alpha + sacc;
            u32x4 pw0, pw1, pw2, pw3;
#define PKW(P, B) cvtpk_s(P[B], P[B + 1])
            pw0 = (u32x4){PKW(p0, 0), PKW(p0, 2), PKW(p0, 4), PKW(p0, 6)}; pw1 = (u32x4){PKW(p0, 8), PKW(p0, 10), PKW(p0, 12), PKW(p0, 14)};
            pw2 = (u32x4){PKW(p1, 0), PKW(p1, 2), PKW(p1, 4), PKW(p1, 6)}; pw3 = (u32x4){PKW(p1, 8), PKW(p1, 10), PKW(p1, 12), PKW(p1, 14)};
#undef PKW
            SBAR(); pv(o, vb0 + slot, __builtin_bit_cast(bf16x8, pw0), __builtin_bit_cast(bf16x8, pw1), __builtin_bit_cast(bf16x8, pw2), __builtin_bit_cast(bf16x8, pw3));
        }
    }
    { auto rr = __builtin_amdgcn_permlane32_swap(__float_as_uint(l_reg), __float_as_uint(l_reg), false, false); l_reg = __uint_as_float(rr[0]) + __uint_as_float(rr[1]); }
    if (hi == 0) wsf[32 + r32] = l_reg; asm volatile("s_waitcnt lgkmcnt(0)" ::: "memory");
    float rli[16];
#pragma unroll
    for (int r = 0; r < 16; ++r) rli[r] = __builtin_amdgcn_rcpf(wsf[32 + crow(r, hi)]);
    bf16* Ow = concat + (rowbase + q0 + wid * 32) * PO + 512 + h * 64;
    { bf16* stg = (bf16*)(shm + LDS_OST) + wid * 2048;
#pragma unroll
      for (int r = 0; r < 16; ++r) { const int orow = crow(r, hi);
#pragma unroll
        for (int d0 = 0; d0 < 2; ++d0) stg[orow * 64 + d0 * 32 + r32] = __float2bfloat16(o[d0][r] * rli[r]); }
      asm volatile("s_waitcnt lgkmcnt(0)" ::: "memory");
#pragma unroll
      for (int i = 0; i < 4; ++i) { const int row = i * 8 + (lane >> 3), ch = lane & 7; const u32x4 v = *(const u32x4*)(stg + row * 64 + ch * 8); *(u32x4*)(Ow + (long)row * PO + ch * 8) = v; } }
    asm volatile("s_waitcnt vmcnt(0) lgkmcnt(0)\n\ts_barrier" ::: "memory");
#undef KROW
#undef DMA_KV
}
#undef SBAR
}
#define GAS __attribute__((address_space(1)))
#define LAS __attribute__((address_space(3)))
typedef unsigned short bf16;
typedef unsigned v4u __attribute__((ext_vector_type(4)));
typedef float f32x4 __attribute__((ext_vector_type(4)));
typedef short bf16x8 __attribute__((ext_vector_type(8)));
typedef GAS unsigned gu32;
typedef GAS unsigned long long gu64;
#define RLX_AGENT __ATOMIC_RELAXED, __HIP_MEMORY_SCOPE_AGENT
#define LDS_WAIT() asm volatile("s_waitcnt lgkmcnt(0)" ::: "memory")
#define VM_WAIT() asm volatile("s_waitcnt vmcnt(0)" ::: "memory")
__device__ __forceinline__ unsigned long long rt() { return __builtin_amdgcn_s_memrealtime(); }
__device__ __forceinline__ unsigned f2bf(float f) { unsigned u = __builtin_bit_cast(unsigned, f); return (u + 0x7fffu + ((u >> 16) & 1u)) >> 16; }
__device__ __forceinline__ unsigned pk2(float lo, float hi) { return f2bf(lo) | (f2bf(hi) << 16); }

#define XB_TMO      128
#define XB_XCNT(j)  (256  + 64 * (j))
#define XB_XSUB(j)  (1280 + 64 * (j))
#define XB_XGEN(j)  (2304 + 64 * (j))
#define XB_TOP      3328
#define XB_TOPGEN   3392
#define XCD_BAR_WORDS 3456
#define XB_SPIN_CAP (1u << 18)

__device__ __forceinline__ unsigned xb_ld(unsigned* p)              { return __hip_atomic_load(p, __ATOMIC_RELAXED, __HIP_MEMORY_SCOPE_AGENT); }
__device__ __forceinline__ unsigned xb_add(unsigned* p, unsigned v) { return __hip_atomic_fetch_add(p, v, __ATOMIC_RELAXED, __HIP_MEMORY_SCOPE_AGENT); }
__device__ __forceinline__ unsigned xb_xcc_id() { return (unsigned)__builtin_amdgcn_s_getreg((3 << 11) | 20) & 0xFu; }
#define XB_SPIN(cond, bar) do { unsigned _sp = 0; while (cond) { __builtin_amdgcn_s_sleep(1); \
    if ((++_sp & 255u) == 0u) { if (xb_ld(&(bar)[XB_TMO])) break; if (_sp > XB_SPIN_CAP) { atomicAdd(&(bar)[XB_TMO], 1u); break; } } } } while (0)

struct XcdBarrier {
    unsigned* bar; unsigned x;
    volatile LAS unsigned* st;
};

__device__ __forceinline__ XcdBarrier xcd_barrier_post(unsigned* bar, volatile LAS unsigned* st) {
    XcdBarrier b; b.bar = bar; b.x = xb_xcc_id(); b.st = st;
    if (threadIdx.x == 0) (void)xb_add(&bar[XB_XCNT(b.x)], 1u);
    return b;
}
__device__ __forceinline__ void xcd_barrier_complete(unsigned* bar, unsigned x, unsigned& nloc, unsigned& nx) {
    const unsigned G = gridDim.x * gridDim.y * gridDim.z;
    unsigned sum, cnt, mine, sp = 0u;
    for (;;) {
        sum = 0u; cnt = 0u; mine = 0u;
#pragma unroll
        for (unsigned j = 0; j < 16; ++j) { const unsigned c = xb_ld(&bar[XB_XCNT(j)]); sum += c; cnt += (c > 0u) ? 1u : 0u; mine = (j == x) ? c : mine; }
        if (sum == G) break;
        __builtin_amdgcn_s_sleep(1);
        if ((++sp & 255u) == 0u) { if (xb_ld(&bar[XB_TMO])) break; if (sp > XB_SPIN_CAP) { atomicAdd(&bar[XB_TMO], 1u); break; } }
    }
    nloc = mine > 0u ? mine : 1u; nx = cnt > 0u ? cnt : 1u;
}

__device__ __forceinline__ void xcd_barrier(const XcdBarrier& b) {
    asm volatile("s_waitcnt vmcnt(0)" ::: "memory");
    __syncthreads();
    if (threadIdx.x == 0) {
        unsigned* bar = b.bar;
        __builtin_amdgcn_s_waitcnt(0);
        unsigned nloc = b.st[0], nx = b.st[1];
        if (nloc == 0u) { xcd_barrier_complete(bar, b.x, nloc, nx); b.st[0] = nloc; b.st[1] = nx; }
        const unsigned old = xb_add(&bar[XB_XSUB(b.x)], 1u);
        const unsigned gen = old / nloc;
        if (old + 1u == (gen + 1u) * nloc) {
            __builtin_amdgcn_fence(__ATOMIC_RELEASE, "agent");
            asm volatile("s_waitcnt vmcnt(0)" ::: "memory");
            const unsigned og = xb_add(&bar[XB_TOP], 1u);
            const unsigned tg = og / nx;
            if (og + 1u == (tg + 1u) * nx) xb_add(&bar[XB_TOPGEN], 1u);
            else XB_SPIN(xb_ld(&bar[XB_TOPGEN]) == tg, bar);
            __builtin_amdgcn_fence(__ATOMIC_ACQUIRE, "agent");
            xb_add(&bar[XB_XGEN(b.x)], 1u);
            asm volatile("s_waitcnt vmcnt(0)" ::: "memory");
        } else {
            XB_SPIN(xb_ld(&bar[XB_XGEN(b.x)]) == gen, bar);
            __builtin_amdgcn_fence(__ATOMIC_ACQUIRE, "agent");
            asm volatile("s_waitcnt vmcnt(0)" ::: "memory");
        }
    }
    __syncthreads();
}
constexpr int NWAVES = 8;
constexpr int DM = 1024, NBATCH = 8, SEQ = 4096, DEPTH = 2, PLE = 256, DFF = 2816, DIN = 2048, NHEAD = 8;
constexpr int M = NBATCH * SEQ;
constexpr float RMS_EPS = 1e-6f;
#ifndef MK_SPLIT
#define MK_SPLIT 0
#endif

constexpr size_t MiB = 1u << 20;
constexpr size_t WS_CTL = 0, CTL_ZERO_BYTES = 1 * MiB;
constexpr size_t WS_LUT = 1 * MiB;
constexpr size_t WS_KMS = 1 * MiB + 64 * 1024;
constexpr size_t WS_W = 2 * MiB, W_LAYER = 25 * MiB;
constexpr size_t OFF_WIN = 0, OFF_WOUT = 4 * MiB, OFF_WUP = 6 * MiB, OFF_WDOWN = 17 * MiB, OFF_WG = 17 * MiB + 5632 * 1024, OFF_WPLE = OFF_WG + 2 * MiB;
static_assert(OFF_WPLE + 512 * 1024 <= W_LAYER, "weights per layer");
constexpr size_t WS_SB = 52 * MiB;
constexpr size_t WS_PB = 64 * MiB;
constexpr size_t WS_E = 96 * MiB;
constexpr size_t WS_HB0 = 160 * MiB, WS_HB1 = 224 * MiB;
constexpr size_t WS_PROJ = 288 * MiB;
constexpr size_t WS_CAT = 416 * MiB;
constexpr size_t WS_HID = 288 * MiB;
constexpr size_t WS_END = 480 * MiB;
constexpr int CW_BAR = 4096;
constexpr int RING_OFF = 0, RING_BYTES = 131072, XCH_OFF = 131072  , LDSCTL_OFF = 135168, MISC_OFF = LDSCTL_OFF + 320, LDS_BYTES = 147456;

__device__ __forceinline__ float wave_sum(float v) {
#pragma unroll
    for (int o = 1; o < 64; o <<= 1) v += __shfl_xor(v, o);
    return v;
}
__device__ __forceinline__ void p0_transpose_item(const float* W, int ldw, int srccol0, const float* ks, int K, bf16* WT, int dstrow0, int k0, LAS float* scr, int lane) {
#pragma unroll 8
    for (int i = 0; i < 32; ++i) { const int kk = 2 * i + (lane >> 5); float v = W[(size_t)(k0 + kk) * ldw + srccol0 + (lane & 31)]; if (ks) v *= ks[k0 + kk]; scr[kk * 33 + (lane & 31)] = v; }
    LDS_WAIT(); asm volatile("" ::: "memory");
    const int c = lane & 7;
#pragma unroll
    for (int j = 0; j < 4; ++j) { const int n = (lane >> 3) + 8 * j; const LAS float* s = scr + (8 * c) * 33 + n;
        v4u o; o.x = pk2(s[0 * 33], s[1 * 33]); o.y = pk2(s[2 * 33], s[3 * 33]); o.z = pk2(s[4 * 33], s[5 * 33]); o.w = pk2(s[6 * 33], s[7 * 33]);
        *(GAS v4u*)(WT + (size_t)(dstrow0 + n) * K + k0 + 8 * c) = o; }
    LDS_WAIT(); asm volatile("" ::: "memory");
}
__device__ __forceinline__ void p0_pool_item(const float* Win, const float* wpool, const float* pscale, const float* g, bf16* WT, int n0, int k0, LAS float* scr, int lane) {
    const int n = n0 + (lane & 31), grp = n >> 7, nl = n & 127; const float* wp = wpool + (size_t)grp * 128 * 128 + nl; const float sc = pscale[n];
    for (int i = 0; i < 32; ++i) { const int kk = 2 * i + (lane >> 5); const float* wr_ = Win + (size_t)(k0 + kk) * DIN + grp * 128; float a = 0.f;
#pragma unroll 8
        for (int c = 0; c < 128; ++c) a = fmaf(wr_[c], wp[(size_t)c * 128], a);
        scr[kk * 33 + (lane & 31)] = a * sc * g[k0 + kk]; }
    LDS_WAIT(); asm volatile("" ::: "memory");
    const int c = lane & 7;
#pragma unroll
    for (int j = 0; j < 4; ++j) { const int nn = (lane >> 3) + 8 * j; const LAS float* s = scr + (8 * c) * 33 + nn;
        v4u o; o.x = pk2(s[0 * 33], s[1 * 33]); o.y = pk2(s[2 * 33], s[3 * 33]); o.z = pk2(s[4 * 33], s[5 * 33]); o.w = pk2(s[6 * 33], s[7 * 33]);
        *(GAS v4u*)(WT + (size_t)(n0 + nn) * DM + k0 + 8 * c) = o; }
    LDS_WAIT(); asm volatile("" ::: "memory");
}
__device__ __forceinline__ void row_norm_to_bf16(const float* xrow, bf16* orow, int lane) {
    const GAS f32x4* xr = (const GAS f32x4*)xrow + lane; f32x4 v[4]; float s = 0.f;
#pragma unroll
    for (int j = 0; j < 4; ++j) { v[j] = xr[64 * j]; s += (v[j].x * v[j].x + v[j].y * v[j].y) + (v[j].z * v[j].z + v[j].w * v[j].w); }
    const float rstd = 1.0f / sqrtf(wave_sum(s) * (1.f / DM) + RMS_EPS);
    GAS unsigned long long* o8 = (GAS unsigned long long*)orow + lane;
#pragma unroll
    for (int j = 0; j < 4; ++j) o8[64 * j] = (unsigned long long)pk2(v[j].x * rstd, v[j].y * rstd) | ((unsigned long long)pk2(v[j].z * rstd, v[j].w * rstd) << 32);
}
template <int MODE> __device__ __forceinline__ void row_res_norm(const float* base, const bf16* yrow, const float* g, float* xout, bf16* ob, int lane) {
    const GAS unsigned long long* yr = (const GAS unsigned long long*)yrow + lane; f32x4 y[4]; float s = 0.f;
#pragma unroll
    for (int j = 0; j < 4; ++j) { const unsigned long long w = yr[64 * j]; const unsigned lo = (unsigned)w, hi = (unsigned)(w >> 32);
        y[j].x = __builtin_bit_cast(float, lo << 16); y[j].y = __builtin_bit_cast(float, lo & 0xffff0000u); y[j].z = __builtin_bit_cast(float, hi << 16); y[j].w = __builtin_bit_cast(float, hi & 0xffff0000u);
        s += (y[j].x * y[j].x + y[j].y * y[j].y) + (y[j].z * y[j].z + y[j].w * y[j].w); }
    const float rstd = 1.0f / sqrtf(wave_sum(s) * (1.f / DM) + RMS_EPS);
    const GAS f32x4* br = (const GAS f32x4*)base + lane; const GAS f32x4* gr = (const GAS f32x4*)g + lane; GAS f32x4* xo = (GAS f32x4*)xout + lane; float s2 = 0.f;
#pragma unroll
    for (int j = 0; j < 4; ++j) { const f32x4 gg = gr[64 * j]; f32x4 x = br[64 * j]; x.x += y[j].x * rstd * gg.x; x.y += y[j].y * rstd * gg.y; x.z += y[j].z * rstd * gg.z; x.w += y[j].w * rstd * gg.w;
        xo[64 * j] = x; y[j] = x; s2 += (x.x * x.x + x.y * x.y) + (x.z * x.z + x.w * x.w); }
    const float r2 = (MODE == 0) ? 1.0f / sqrtf(wave_sum(s2) * (1.f / DM) + RMS_EPS) : 1.0f;
    GAS unsigned long long* o8 = (GAS unsigned long long*)ob + lane;
#pragma unroll
    for (int j = 0; j < 4; ++j) o8[64 * j] = (unsigned long long)pk2(y[j].x * r2, y[j].y * r2) | ((unsigned long long)pk2(y[j].z * r2, y[j].w * r2) << 32);
}
__device__ __forceinline__ int rel_bucket(int n) {
    if (n < 16) return n;
    const int large = 16 + (int)(logf((float)n / 16.f) / logf(8.f) * 16.f);
    return large < 31 ? large : 31;
}

struct Args { const float* in[17]; float* out; unsigned char* ws; int ph_lo, ph_hi; };
static_assert(sizeof(Args) == 17 * 8 + 8 + 8 + 8, "Args has no padding bytes");

__global__ void __launch_bounds__(NWAVES * 64, 2) mk_fwd(Args args) {
    extern __shared__ __attribute__((aligned(16))) unsigned char lds[];
    LAS unsigned char* L = (LAS unsigned char*)lds;
    volatile LAS unsigned* MISC = (volatile LAS unsigned*)(L + MISC_OFF);
    const int G = gridDim.x; const int bx = blockIdx.x; const int vcu = (G % 8 == 0) ? (bx % 8) * (G / 8) + bx / 8 : bx;
    unsigned char* ws = args.ws;
    gu32* ctl = (gu32*)(ws + WS_CTL);
    for (int u = threadIdx.x; u < (LDS_BYTES - LDSCTL_OFF) / 4; u += NWAVES * 64) ((LAS unsigned*)(L + LDSCTL_OFF))[u] = 0u;
    __syncthreads();
    XcdBarrier bar; bar.bar = (unsigned*)(ctl + CW_BAR); bar.x = 0; bar.st = nullptr;
    if (!MK_SPLIT) bar = xcd_barrier_post((unsigned*)(ctl + CW_BAR), MISC + 8);
    const int NGW = G * NWAVES;
#pragma unroll 1
    for (int ph = args.ph_lo; ph < args.ph_hi; ++ph) {
        float* out = args.out;
        int tid_op = threadIdx.x; asm volatile("" : "+v"(tid_op));
        const int tid = tid_op, lane = tid & 63, wave = __builtin_amdgcn_readfirstlane(tid >> 6); const int gw = vcu * NWAVES + wave;
        if (ph == 0) {
            const float* w_in = args.in[7]; const float* g_mix_pre = args.in[3]; const float* g_ffn_pre = args.in[5];
            LAS float* scr = (LAS float*)(L + RING_OFF + wave * 16384);
            constexpr int I_IN = (DM / 64) * (DIN / 32), I_OUT = (DM / 64) * (DM / 32), I_UP = (DM / 64) * (2 * DFF / 32), I_DOWN = (DFF / 64) * (DM / 32), I_G = I_OUT, I_PLE = (PLE / 64) * (DM / 32);
            constexpr int I_LAYER = I_IN + I_OUT + I_UP + I_DOWN + I_G + I_PLE;
#pragma unroll 1
            for (int it = gw; it < DEPTH * I_LAYER; it += NGW) {
                const int ly = it / I_LAYER; int r = it % I_LAYER;
                unsigned char* wb = ws + WS_W + (size_t)ly * W_LAYER;
                if (r < I_IN) { const int nblk = DIN / 32, kb = r / nblk, nb = r % nblk;
                    if (nb < 16) p0_pool_item(w_in + (size_t)ly * DM * DIN, args.in[8] + (size_t)ly * 4 * 128 * 128, args.in[9] + ly * 512, g_mix_pre + ly * DM, (bf16*)(wb + OFF_WIN), 32 * nb, 64 * kb, scr, lane);
                    else p0_transpose_item(w_in + (size_t)ly * DM * DIN, DIN, 32 * nb, g_mix_pre + ly * DM, DM, (bf16*)(wb + OFF_WIN), 32 * nb, 64 * kb, scr, lane);
                    continue; } r -= I_IN;
                const float* W; int ldw, srccol0, K, dstrow0, k0; const float* ks = nullptr; bf16* WT;
                if (r < I_OUT) { const int nblk = DM / 32, kb = r / nblk, nb = r % nblk; W = args.in[10] + (size_t)ly * DM * DM; ldw = DM; srccol0 = 32 * nb; K = DM; WT = (bf16*)(wb + OFF_WOUT); dstrow0 = 32 * nb; k0 = 64 * kb; }
                else if ((r -= I_OUT) < I_UP) { const int nblk = 2 * DFF / 32, kb = r / nblk, nb = r % nblk; const int R0 = 32 * nb, pn = R0 >> 8, bj = (R0 >> 7) & 1, i0 = R0 & 127;
                    W = args.in[11] + (size_t)ly * DM * 2 * DFF; ldw = 2 * DFF; srccol0 = bj * DFF + pn * 128 + i0; ks = g_ffn_pre + ly * DM; K = DM; WT = (bf16*)(wb + OFF_WUP); dstrow0 = R0; k0 = 64 * kb; }
                else if ((r -= I_UP) < I_DOWN) { const int nblk = DM / 32, kb = r / nblk, nb = r % nblk; W = args.in[14] + (size_t)ly * DFF * DM; ldw = DM; srccol0 = 32 * nb; K = DFF; WT = (bf16*)(wb + OFF_WDOWN); dstrow0 = 32 * nb; k0 = 64 * kb; }
                else if ((r -= I_DOWN) < I_G) { const int nblk = DM / 32, kb = r / nblk, nb = r % nblk; W = args.in[16] + (size_t)ly * DM * DM; ldw = DM; srccol0 = 32 * nb; K = DM; WT = (bf16*)(wb + OFF_WG); dstrow0 = 32 * nb; k0 = 64 * kb; }
                else { r -= I_G; const int nblk = DM / 32, kb = r / nblk, nb = r % nblk; W = args.in[15] + (size_t)ly * PLE * DM; ldw = DM; srccol0 = 32 * nb; K = PLE; WT = (bf16*)(wb + OFF_WPLE); dstrow0 = 32 * nb; k0 = 64 * kb; }
                p0_transpose_item(W, ldw, srccol0, ks, K, WT, dstrow0, k0, scr, lane);
            }
            { const float* p_in = args.in[1]; bf16* PB = (bf16*)(ws + WS_PB);
              const size_t n8 = (size_t)DEPTH * M * PLE / 8; const size_t gt = (size_t)vcu * (NWAVES * 64) + tid, GT = (size_t)G * NWAVES * 64;
              for (size_t i = gt; i < n8; i += GT) { const f32x4 a = ((const GAS f32x4*)p_in)[2 * i], b = ((const GAS f32x4*)p_in)[2 * i + 1];
                  v4u o; o.x = pk2(a.x, a.y); o.y = pk2(a.z, a.w); o.z = pk2(b.x, b.y); o.w = pk2(b.z, b.w); ((GAS v4u*)PB)[i] = o; } }
            { const float* x_in = args.in[0];
              for (int m = gw; m < M; m += NGW) row_norm_to_bf16(x_in + (size_t)m * DM, (bf16*)(ws + WS_HB0) + (size_t)m * DM, lane); }
            if (bx == 0) { const float* rel_bias = args.in[2]; float* lutg = (float*)(ws + WS_LUT);
                for (int i = tid; i < 8 * 128; i += NWAVES * 64) { const int h = i >> 7, d = i & 127; lutg[i] = rel_bias[rel_bucket(d) * NHEAD + h] * 1.4426950408889634f; } }
        } else {
            const int q = ph - 1, ly = q / 10, st = q - 10 * ly;
            unsigned char* wb = ws + WS_W + (size_t)ly * W_LAYER;
            bf16* HBa = (bf16*)(ws + ((ly & 1) ? WS_HB1 : WS_HB0));
            bf16* HBb = (bf16*)(ws + ((ly & 1) ? WS_HB0 : WS_HB1));
            bf16* EB = (bf16*)(ws + WS_E);
            if (st == 1) {
                const moba::bf16* PROJ = (const moba::bf16*)(ws + WS_PROJ); moba::bf16* CAT = (moba::bf16*)(ws + WS_CAT); const float* kms = (const float*)(ws + WS_KMS); const float* lutg = (const float*)(ws + WS_LUT);
                if (G == 256) { const int bh = vcu >> 2, s = vcu & 3;
#pragma unroll 1
                    for (int i = 0; i < 4; ++i) { const int j = (i == 0) ? 2 * s : (i == 1) ? 15 - 2 * s : (i == 2) ? 2 * s + 1 : 14 - 2 * s;
                        moba::moba_unit(bh >> 3, bh & 7, j, PROJ, CAT, kms, lutg, (char*)lds + RING_OFF); } }
                else {
#pragma unroll 1
                    for (int u = vcu; u < 1024; u += G) moba::moba_unit(u >> 7, (u >> 4) & 7, u & 15, PROJ, CAT, kms, lutg, (char*)lds + RING_OFF); }
            } else if (st == 3) {
                const float* xbase = (ly == 0) ? args.in[0] : out; const float* gp = args.in[4] + ly * DM;
#pragma unroll 1
                for (int m = gw; m < M; m += NGW) row_res_norm<0>(xbase + (size_t)m * DM, EB + (size_t)m * DM, gp, out + (size_t)m * DM, HBb + (size_t)m * DM, lane);
            } else if (st == 6) {
                const float* gp = args.in[6] + ly * DM;
#pragma unroll 1
                for (int m = gw; m < M; m += NGW) row_res_norm<1>(out + (size_t)m * DM, EB + (size_t)m * DM, gp, out + (size_t)m * DM, HBa + (size_t)m * DM, lane);
            } else if (st == 9) {
#pragma unroll 1
                for (int m = gw; m < M; m += NGW) row_norm_to_bf16(out + (size_t)m * DM, HBb + (size_t)m * DM, lane);
            } else {
                pg8::Gemm g; pg8::EpiAny E; E.mode = 0; E.O = EB; E.ldc = DM; E.kms = (float*)(ws + WS_KMS); E.cw = args.in[12] + (size_t)ly * 3 * DFF; E.cb = args.in[13] + (size_t)ly * DFF;
                E.sb = (float*)(ws + WS_SB); E.X = (LAS float*)(L + XCH_OFF); E.Xo = out; E.E = EB;
                g.M = M; g.N = DM; g.K = DM;
                if (st == 0) { g.A = HBa; g.Bt = (const bf16*)(wb + OFF_WIN); g.N = DIN; E.mode = 1; E.O = (bf16*)(ws + WS_PROJ); }
                else if (st == 2) { g.A = (const bf16*)(ws + WS_CAT); g.Bt = (const bf16*)(wb + OFF_WOUT); }
                else if (st == 4) { g.A = HBb; g.Bt = (const bf16*)(wb + OFF_WUP); g.N = 2 * DFF; E.mode = 2; E.O = (bf16*)(ws + WS_HID); }
                else if (st == 5) { g.A = (const bf16*)(ws + WS_HID); g.Bt = (const bf16*)(wb + OFF_WDOWN); g.K = DFF; }
                else if (st == 7) { g.A = (const bf16*)(ws + WS_PB) + (size_t)ly * M * PLE; g.Bt = (const bf16*)(wb + OFF_WPLE); g.K = PLE; }
                else { g.A = HBa; g.Bt = (const bf16*)(wb + OFF_WG); E.mode = 3; }
                pg8::StaticOrder S; S.init(M, g.N, G, bx);
                if (st == 5) {
                    bf16* HID = (bf16*)(ws + WS_HID); const float* sbuf = (const float*)(ws + WS_SB); pg8::Unit u;
#pragma unroll 1
                    for (int i = 0; S.next(i, u); ++i) { const int pm = u.pm; if ((pm & 15) == 0) continue;
#pragma unroll 1
                        for (int c = tid; c < DFF; c += NWAVES * 64) {
                            const float t2 = sbuf[(((size_t)(pm - 1) * 3 + 0) * 2 + 0) * DFF + c], t1 = sbuf[(((size_t)(pm - 1) * 3 + 0) * 2 + 1) * DFF + c];
                            const float g0 = sbuf[(((size_t)pm * 3 + 1) * 2 + 0) * DFF + c], g1 = sbuf[(((size_t)pm * 3 + 1) * 2 + 1) * DFF + c];
                            const float v0 = sbuf[(((size_t)pm * 3 + 2) * 2 + 0) * DFF + c], v1 = sbuf[(((size_t)pm * 3 + 2) * 2 + 1) * DFF + c];
                            const float w0 = E.cw[c], w1 = E.cw[DFF + c], w2 = E.cw[2 * DFF + c], b_ = E.cb[c];
                            const float c0 = b_ + w0 * t2 + w1 * t1 + w2 * g0, c1 = b_ + w0 * t1 + w1 * g0 + w2 * g1;
                            HID[(size_t)(pm * 256) * DFF + c] = (bf16)f2bf(pg8::gelu_tanh_f(c0) * v0); HID[(size_t)(pm * 256 + 1) * DFF + c] = (bf16)f2bf(pg8::gelu_tanh_f(c1) * v1); } }
                    VM_WAIT(); __syncthreads();
                }
                pg8::gemm_phase<pg8::EpiAny, pg8::StaticOrder, true, true>(L + RING_OFF, g, S, E);
            }
        }
        if (!MK_SPLIT && ph + 1 < args.ph_hi) xcd_barrier(bar);
    }
}
constexpr int N_PHASES = 1 + DEPTH * 10 - 1;

extern "C" void kernel_launch(void* const* d_in, const int* in_sizes, int n_in, void* d_out, int out_size, void* d_ws, size_t ws_size, hipStream_t stream) {
    static int grid = 0;
    if (grid == 0) {
        if (n_in != 17 || out_size != M * DM || ws_size < WS_END) { fprintf(stderr, "kernel_launch: unexpected shapes (n_in %d, out %d, ws %zu)\n", n_in, out_size, ws_size); grid = -1; return; }
        int dev = 0, cus = 0, per_cu = 0;
        if (hipGetDevice(&dev) != hipSuccess || hipDeviceGetAttribute(&cus, hipDeviceAttributeMultiprocessorCount, dev) != hipSuccess) { grid = -1; return; }
        if (hipFuncSetAttribute((const void*)mk_fwd, hipFuncAttributeMaxDynamicSharedMemorySize, LDS_BYTES) != hipSuccess) { fprintf(stderr, "kernel_launch: hipFuncSetAttribute failed\n"); grid = -1; return; }
        if (hipOccupancyMaxActiveBlocksPerMultiprocessor(&per_cu, (const void*)mk_fwd, NWAVES * 64, LDS_BYTES) != hipSuccess || per_cu < 1) { fprintf(stderr, "kernel_launch: occupancy query says %d blocks per CU\n", per_cu); (void)hipGetLastError(); }
        grid = cus;
    }
    if (grid < 0) return;
    (void)hipMemsetAsync((char*)d_ws + WS_CTL, 0, CTL_ZERO_BYTES, stream);
    Args a{};
    for (int i = 0; i < 17; ++i) a.in[i] = (const float*)d_in[i];
    a.out = (float*)d_out; a.ws = (unsigned char*)d_ws;
#if MK_SPLIT
    for (int p = 0; p < N_PHASES; ++p) { a.ph_lo = p; a.ph_hi = p + 1; hipLaunchKernelGGL(mk_fwd, dim3(grid), dim3(NWAVES * 64), LDS_BYTES, stream, a); }
#else
    a.ph_lo = 0; a.ph_hi = N_PHASES;
    void* kargs[] = {&a};
    hipError_t e = hipLaunchCooperativeKernel((const void*)mk_fwd, dim3(grid), dim3(NWAVES * 64), kargs, LDS_BYTES, stream);
    if (e != hipSuccess) { fprintf(stderr, "kernel_launch: cooperative launch failed: %s\n", hipGetErrorString(e)); }
#endif
}
```
